# Optimizing an MI355X kernel written in HIP

```python
import jax, jax.numpy as jnp
from jax import lax
import numpy as np

D_MODEL = 1024
BATCH = 4
SEQ = 8192
DEPTH = 4
DEC_BATCH = 8
DEC_SEQ = 64
PAST_LEN = 2048

CHUNK = 64
N_A = DEPTH // 2
N_B = DEPTH - N_A
A_CHUNK = 128
A_WIDTH = D_MODEL
A_GROUPS = 8
A_GROUP_DIM = A_WIDTH // A_GROUPS
N_HEADS = 16
QK_NOPE = 64
QK_ROPE = 32
V_DIM = 64
KV_LORA = 128
Q_LORA = 256
D_FF = 2816
ROPE_BASE = 10000.0
EPS = 1e-6
Q_BLOCK = 128
ATT_SCALE = (QK_NOPE + QK_ROPE) ** -0.5

kernel_name = 'yoco_gmlp_mla_macaron_stream_step'


def rmsnorm(x, g):
    x32 = x.astype(jnp.float32)
    y = x32 * lax.rsqrt(jnp.mean(x32 * x32, axis=-1, keepdims=True) + EPS)
    return (y * g.astype(jnp.float32)).astype(x.dtype)


def swiglu(x, w_gu, w_down):
    g, u = jnp.split(x @ w_gu, 2, axis=-1)
    return (jax.nn.silu(g) * u) @ w_down


def rope(x, pos):
    half = QK_ROPE // 2
    inv = 1.0 / (ROPE_BASE ** (jnp.arange(half, dtype=jnp.float32) * (2.0 / QK_ROPE)))
    ang = pos.astype(jnp.float32)[:, None] * inv[None, :]
    shape = (ang.shape[0],) + (1,) * (x.ndim - 3) + (half,)
    cos = jnp.cos(ang).reshape(shape)
    sin = jnp.sin(ang).reshape(shape)
    x32 = x.astype(jnp.float32)
    x1, x2 = x32[..., :half], x32[..., half:]
    return jnp.concatenate([x1 * cos - x2 * sin, x2 * cos + x1 * sin], axis=-1).astype(x.dtype)


def spatial_gate(v, w_s, b_s):
    L = v.shape[-3]
    mask = jnp.tril(jnp.ones((L, L), dtype=bool))
    w = jnp.where(mask, w_s[:, :L, :L], jnp.zeros((), w_s.dtype))
    return jnp.einsum('gts,...sgd->...tgd', w, v) + b_s[:, :L].T[:, :, None]


def gmlp_mixer(h, w_in, v_g, w_s, b_s, w_out, chunked):
    z = jax.nn.gelu(h @ w_in, approximate=False)
    u, v = jnp.split(z, 2, axis=-1)
    v = rmsnorm(v, v_g)
    bsz, s, _ = v.shape
    if chunked:
        vb = v.reshape(bsz, s // A_CHUNK, A_CHUNK, A_GROUPS, A_GROUP_DIM)
    else:
        vb = v.reshape(bsz, s, A_GROUPS, A_GROUP_DIM)
    sv = spatial_gate(vb, w_s, b_s).reshape(bsz, s, A_WIDTH)
    return (u * sv) @ w_out, v


def mla_latent(h, kv_g, w_dkv, ckv_g, pos):
    kv = rmsnorm(h, kv_g) @ w_dkv
    ckv = rmsnorm(kv[..., :KV_LORA], ckv_g)
    kr = rope(kv[..., KV_LORA:], pos)
    return ckv, kr


def mla_expand(ckv, w_uk, w_uv):
    bsz, s, _ = ckv.shape
    kn = (ckv @ w_uk).reshape(bsz, s, N_HEADS, QK_NOPE)
    vv = (ckv @ w_uv).reshape(bsz, s, N_HEADS, V_DIM)
    return kn, vv


def mla_queries(h, w_dq, q_g, w_uq, pos):
    bsz, s, _ = h.shape
    q = (rmsnorm(h @ w_dq, q_g) @ w_uq).reshape(bsz, s, N_HEADS, QK_NOPE + QK_ROPE)
    return q[..., :QK_NOPE], rope(q[..., QK_NOPE:], pos)


def attend(qn, qr, kn, kr, vv, mask):
    s = jnp.einsum('bqhd,bkhd->bhqk', qn, kn) + jnp.einsum('bqhr,bkr->bhqk', qr, kr)
    s = s.astype(jnp.float32) * ATT_SCALE
    if mask is not None:
        s = jnp.where(mask[None, None], s, -jnp.inf)
    p = jax.nn.softmax(s, axis=-1).astype(vv.dtype)
    return jnp.einsum('bhqk,bkhd->bqhd', p, vv)


def mla_prompt_attention(qn, qr, kn, kr, vv):
    bsz, s = qn.shape[:2]
    nqb = s // Q_BLOCK
    qn_b = qn.reshape(bsz, nqb, Q_BLOCK, N_HEADS, QK_NOPE).transpose(1, 0, 2, 3, 4)
    qr_b = qr.reshape(bsz, nqb, Q_BLOCK, N_HEADS, QK_ROPE).transpose(1, 0, 2, 3, 4)
    k_chunk = jnp.arange(s) // CHUNK

    def block(args):
        qn_i, qr_i, i = args
        q_chunk = (i * Q_BLOCK + jnp.arange(Q_BLOCK)) // CHUNK
        mask = k_chunk[None, :] <= q_chunk[:, None]
        return attend(qn_i, qr_i, kn, kr, vv, mask)

    o = lax.map(block, (qn_b, qr_b, jnp.arange(nqb)))
    return o.transpose(1, 0, 2, 3, 4).reshape(bsz, s, N_HEADS * V_DIM)


def setup_inputs(seed: int = 0) -> dict:
    key = jax.random.key(seed)
    ks = jax.random.split(key, 32)

    def nrm(k, shape, scale):
        return jax.random.normal(k, shape, jnp.float32) * scale

    def gain(k, shape):
        return 1.0 + 0.01 * jax.random.normal(k, shape, jnp.float32)

    return {
        'x_prompt': nrm(ks[0], (BATCH, SEQ, D_MODEL), 1.0),
        'x_sample': nrm(ks[1], (DEC_BATCH, DEC_SEQ, D_MODEL), 1.0),
        'cache_ckv': nrm(ks[2], (DEC_BATCH, PAST_LEN, KV_LORA), 1.0),
        'cache_krope': nrm(ks[3], (DEC_BATCH, PAST_LEN, QK_ROPE), 1.0),
        'ffn1_norm': gain(ks[4], (DEPTH, D_MODEL)),
        'ffn1_w_gu': nrm(ks[5], (DEPTH, D_MODEL, 2 * D_FF), D_MODEL ** -0.5),
        'ffn1_w_down': nrm(ks[6], (DEPTH, D_FF, D_MODEL), D_FF ** -0.5),
        'mix_norm': gain(ks[7], (DEPTH, D_MODEL)),
        'ffn2_norm': gain(ks[8], (DEPTH, D_MODEL)),
        'ffn2_w_gu': nrm(ks[9], (DEPTH, D_MODEL, 2 * D_FF), D_MODEL ** -0.5),
        'ffn2_w_down': nrm(ks[10], (DEPTH, D_FF, D_MODEL), D_FF ** -0.5),
        'a_w_in': nrm(ks[11], (N_A, D_MODEL, 2 * A_WIDTH), D_MODEL ** -0.5),
        'a_v_norm': gain(ks[12], (N_A, A_WIDTH)),
        'a_w_s': nrm(ks[13], (N_A, A_GROUPS, A_CHUNK, A_CHUNK), A_CHUNK ** -0.5),
        'a_b_s': 1.0 + 0.02 * jax.random.normal(ks[14], (N_A, A_GROUPS, A_CHUNK), jnp.float32),
        'a_w_out': nrm(ks[15], (N_A, A_WIDTH, D_MODEL), A_WIDTH ** -0.5),
        'kv_norm': gain(ks[16], (D_MODEL,)),
        'w_dkv': nrm(ks[17], (D_MODEL, KV_LORA + QK_ROPE), D_MODEL ** -0.5),
        'ckv_norm': gain(ks[18], (KV_LORA,)),
        'w_uk': nrm(ks[19], (KV_LORA, N_HEADS * QK_NOPE), KV_LORA ** -0.5),
        'w_uv': nrm(ks[20], (KV_LORA, N_HEADS * V_DIM), KV_LORA ** -0.5),
        'b_w_dq': nrm(ks[21], (N_B, D_MODEL, Q_LORA), D_MODEL ** -0.5),
        'b_q_norm': gain(ks[22], (N_B, Q_LORA)),
        'b_w_uq': nrm(ks[23], (N_B, Q_LORA, N_HEADS * (QK_NOPE + QK_ROPE)), Q_LORA ** -0.5),
        'b_w_o': nrm(ks[24], (N_B, N_HEADS * V_DIM, D_MODEL), (N_HEADS * V_DIM) ** -0.5),
        'final_norm': gain(ks[25], (D_MODEL,)),
    }


def reference(x_prompt, x_sample, cache_ckv, cache_krope,
              ffn1_norm, ffn1_w_gu, ffn1_w_down, mix_norm, ffn2_norm, ffn2_w_gu, ffn2_w_down,
              a_w_in, a_v_norm, a_w_s, a_b_s, a_w_out,
              kv_norm, w_dkv, ckv_norm, w_uk, w_uv,
              b_w_dq, b_q_norm, b_w_uq, b_w_o, final_norm):

    def run(x, pos, is_prompt, past_ckv, past_krope):
        h = x
        a_v_rows = []
        ckv_new = kr_new = kn = kr_all = vv = None
        for l in range(DEPTH):
            h = h + 0.5 * swiglu(rmsnorm(h, ffn1_norm[l]), ffn1_w_gu[l], ffn1_w_down[l])
            hn = rmsnorm(h, mix_norm[l])
            if l < N_A:
                y, v_rows = gmlp_mixer(hn, a_w_in[l], a_v_norm[l], a_w_s[l], a_b_s[l], a_w_out[l], is_prompt)
                a_v_rows.append(v_rows)
            else:
                j = l - N_A
                qn, qr = mla_queries(hn, b_w_dq[j], b_q_norm[j], b_w_uq[j], pos)
                if is_prompt:
                    o = mla_prompt_attention(qn, qr, kn, kr_all, vv)
                else:
                    o = attend(qn, qr, kn, kr_all, vv, None).reshape(x.shape[0], x.shape[1], N_HEADS * V_DIM)
                y = o @ b_w_o[j]
            h = h + y
            h = h + 0.5 * swiglu(rmsnorm(h, ffn2_norm[l]), ffn2_w_gu[l], ffn2_w_down[l])
            if l == N_A - 1:
                ckv_new, kr_new = mla_latent(h, kv_norm, w_dkv, ckv_norm, pos)
                if is_prompt:
                    ckv_all, kr_all = ckv_new, kr_new
                else:
                    ckv_all = jnp.concatenate([past_ckv, ckv_new], axis=1)
                    kr_all = jnp.concatenate([past_krope, kr_new], axis=1)
                kn, vv = mla_expand(ckv_all, w_uk, w_uv)
        return rmsnorm(h, final_norm), ckv_new, kr_new, a_v_rows

    pos_p = jnp.arange(x_prompt.shape[1])
    y_prompt, new_ckv_prompt, new_krope_prompt, _ = run(x_prompt, pos_p, True, None, None)

    pos_s = PAST_LEN + jnp.arange(x_sample.shape[1])
    y_sample, new_ckv_sample, new_krope_sample, a_rows = run(x_sample, pos_s, False, cache_ckv, cache_krope)
    new_a_v_sample = jnp.stack(a_rows, axis=0)

    return (y_prompt, y_sample, new_ckv_prompt, new_krope_prompt, new_ckv_sample, new_krope_sample, new_a_v_sample)
```

```cpp
#include <hip/hip_runtime.h>
#include <hip/hip_cooperative_groups.h>
#include <cstdio>
#include <cstdint>
namespace cg = cooperative_groups;
__device__ __forceinline__ int opaque_tid() { int t = threadIdx.x; asm volatile("" : "+v"(t)); return t; }
namespace pg8 {
#define PG8_LAS __attribute__((address_space(3)))
typedef unsigned short bf16_t;
typedef short bf16x8 __attribute__((ext_vector_type(8)));
typedef float f32x4 __attribute__((ext_vector_type(4)));
typedef unsigned u32x4 __attribute__((ext_vector_type(4)));
constexpr int BM = 256, BK = 64, HALF = 128, HTB = HALF * BK * 2  , STAGE_BYTES = 8 * HTB, NXCD = 8, WGM = 8;

__host__ __device__ __forceinline__ int lds_byte(int r, int c) { const int st = (r >> 4) * 2 + (c >> 5), rr = r & 15, cc = c & 31, ob = rr * 64 + cc * 2; return st * 1024 + (ob ^ (((ob >> 9) & 1) << 5)); }
__host__ __device__ __forceinline__ void stage_rc(int b, int& R, int& C) { const int st = b / 1024, sb = b % 1024, swz = sb ^ (((sb >> 9) & 1) << 5); R = (st >> 1) * 16 + swz / 64; C = (st & 1) * 32 + (swz % 64) / 2; }
__host__ __device__ __forceinline__ int perm32(int rho) { const int n = rho >> 4, i = rho & 15; return 8 * (i >> 2) + 4 * n + (i & 3); }

struct Unit { int pm, pn; };
struct Gemm { const bf16_t* A; const bf16_t* Bt; int M, N, K; };

struct StaticOrder {
    int nM, nN, nwg, G, c;
    __host__ __device__ void init(int M, int N, int G_, int c_) { nM = M / BM; nN = N / BM; nwg = nM * nN; G = G_; c = c_; }
    __host__ __device__ bool next(int i, Unit& u) const { return at(i * G + c, u); }
    __host__ __device__ bool at(int L, Unit& u) const {
        if (L >= nwg) return false;
        int wgid = (int)L; { const int q = nwg / NXCD, r = nwg % NXCD, xcd = wgid % NXCD, off = wgid / NXCD; wgid = (xcd < r ? xcd * (q + 1) : r * (q + 1) + (xcd - r) * q) + off; }
        const int nig = WGM * nN, gid = wgid / nig, fm = gid * WGM, gsz = (nM - fm) < WGM ? (nM - fm) : WGM;
        u.pm = fm + ((wgid % nig) % gsz); u.pn = (wgid % nig) / gsz; return true;
    }
    __device__ __forceinline__ void a_ready(const Unit&) const {}
    __device__ __forceinline__ void done(const Unit&) const {}
};

struct FfnOrder {
    StaticOrder so; int mode;
    __device__ __forceinline__ bool next(int i, Unit& u) const {
        const int c = so.c;
        if (mode == 0) { if (i > 0 || c >= 44) return false; u.pm = 128 + c / 22; u.pn = c % 22; return true; }
        if (mode == 1) { if (i > 0 || c >= 8) return false; u.pm = 128 + (c >> 2); u.pn = c & 3; return true; }
        int L;
        if (c < 8) { if (i >= 6) return false; L = i * so.G + c; }
        else if (i < 11) L = i * so.G + c;
        else if (i == 11 && c >= 44 && c < 84) { const int k = c - 44; L = (6 + (k >> 3)) * so.G + (k & 7); }
        else return false;
        return so.at(L, u);
    }
    __device__ __forceinline__ void a_ready(const Unit&) const {}
    __device__ __forceinline__ void done(const Unit&) const {}
};

typedef float f32x2 __attribute__((ext_vector_type(2)));
__device__ __forceinline__ f32x2 gelu_pk(f32x2 v) {
    const f32x2 av = __builtin_elementwise_abs(v), d = av * 0.2316418882f + 1.0f;
    f32x2 t; t.x = __builtin_amdgcn_rcpf(d.x); t.y = __builtin_amdgcn_rcpf(d.y);
    f32x2 q = t * 0.5307027145f + (-0.7265760135f); q = q * t + 0.7107068705f; q = q * t + (-0.142248368f); q = q * t + 0.127414796f; q = q * t;
    const f32x2 s = (v * v) * (-0.72134752044f);
    f32x2 e; e.x = __builtin_amdgcn_exp2f(s.x); e.y = __builtin_amdgcn_exp2f(s.y);
    const f32x2 m = v * (q * e), r = v - m;
    f32x2 o; o.x = v.x < 0.f ? m.x : r.x; o.y = v.y < 0.f ? m.y : r.y; return o;
}
typedef float f32x2_t __attribute__((ext_vector_type(2))); typedef __bf16 bf16x2_t __attribute__((ext_vector_type(2)));
typedef unsigned u32x2 __attribute__((ext_vector_type(2)));
__device__ __forceinline__ unsigned cvtpk(float lo, float hi) { f32x2_t v = {lo, hi}; bf16x2_t b = __builtin_convertvector(v, bf16x2_t); return __builtin_bit_cast(unsigned, b); }
__device__ __forceinline__ float ld_stat(const float* p) { return __hip_atomic_load(p, __ATOMIC_RELAXED, __HIP_MEMORY_SCOPE_AGENT); }
__device__ __forceinline__ void add_stat(float* p, float v) { (void)__hip_atomic_fetch_add(p, v, __ATOMIC_RELAXED, __HIP_MEMORY_SCOPE_AGENT); }
__device__ __forceinline__ float rstd_of(const float* ss, int row, float invd) { return __builtin_amdgcn_rsqf(ld_stat(ss + row) * invd + 1e-6f); }
__device__ __forceinline__ float red_fq(float s) { s += __shfl_xor(s, 16); s += __shfl_xor(s, 32); return s; }

struct EpiGU { static constexpr bool PERM = true, AFTER_DRAIN = false;
    bf16_t* H; const float* ss;
    __device__ __forceinline__ void operator()(const f32x4 (&acc)[2][2][4][2], const Unit& u, int wr, int wc, int fr, int fq) const {
        const int row0 = u.pm * BM + wr * 64 + fr, col0 = u.pn * 128 + wc * 32 + 8 * fq;
#pragma unroll
        for (int ai = 0; ai < 2; ++ai)
#pragma unroll
            for (int m = 0; m < 4; ++m) { const int row = row0 + ai * HALF + m * 16; const float r = rstd_of(ss, row, 1.f / 1024.f);
                float o[8];
#pragma unroll
                for (int n = 0; n < 2; ++n)
#pragma unroll
                    for (int j = 0; j < 4; ++j) { const float g = acc[ai][0][m][n][j] * r, uu = acc[ai][1][m][n][j] * r;
                        o[n * 4 + j] = g * uu * __builtin_amdgcn_rcpf(1.f + __builtin_amdgcn_exp2f(-1.4426950408889634f * g)); }
                u32x4 w; w.x = cvtpk(o[0], o[1]); w.y = cvtpk(o[2], o[3]); w.z = cvtpk(o[4], o[5]); w.w = cvtpk(o[6], o[7]);
                *(u32x4*)(H + (size_t)row * 2816 + col0) = w; }
    }
};
struct EpiRes { static constexpr bool PERM = true, AFTER_DRAIN = false;
    const float* base; float* h; bf16_t* hb; float* ssn; float alpha;
    __device__ __forceinline__ void operator()(const f32x4 (&acc)[2][2][4][2], const Unit& u, int wr, int wc, int fr, int fq) const {
        const int row0 = u.pm * BM + wr * 64 + fr, col0 = u.pn * BM + wc * 32 + 8 * fq;
#pragma unroll
        for (int ai = 0; ai < 2; ++ai)
#pragma unroll
            for (int m = 0; m < 4; ++m) { const int row = row0 + ai * HALF + m * 16; float s = 0.f;
#pragma unroll
                for (int bj = 0; bj < 2; ++bj) { const size_t off = (size_t)row * 1024 + col0 + bj * HALF;
                    f32x4 v0 = *(const f32x4*)(base + off), v1 = *(const f32x4*)(base + off + 4);
                    v0 = v0 + acc[ai][bj][m][0] * alpha; v1 = v1 + acc[ai][bj][m][1] * alpha;
                    *(f32x4*)(h + off) = v0; *(f32x4*)(h + off + 4) = v1;
                    u32x4 w; w.x = cvtpk(v0[0], v0[1]); w.y = cvtpk(v0[2], v0[3]); w.z = cvtpk(v1[0], v1[1]); w.w = cvtpk(v1[2], v1[3]); *(u32x4*)(hb + off) = w;
                    s += (v0[0] * v0[0] + v0[1] * v0[1]) + (v0[2] * v0[2] + v0[3] * v0[3]) + (v1[0] * v1[0] + v1[1] * v1[1]) + (v1[2] * v1[2] + v1[3] * v1[3]); }
                if (ssn) { s = red_fq(s); if (fq == 0) add_stat(ssn + row, s); }
                asm volatile("" ::: "memory"); }
    }
};
struct EpiWin { static constexpr bool PERM = true, AFTER_DRAIN = false;
    bf16_t* Z; const float* ss; float* ssv;
    __device__ __forceinline__ void operator()(const f32x4 (&acc)[2][2][4][2], const Unit& u, int wr, int wc, int fr, int fq) const {
        const int row0 = u.pm * BM + wr * 64 + fr, col0 = u.pn * BM + wc * 32 + 8 * fq;
#pragma unroll
        for (int ai = 0; ai < 2; ++ai)
#pragma unroll
            for (int m = 0; m < 4; ++m) { const int row = row0 + ai * HALF + m * 16; const float r = rstd_of(ss, row, 1.f / 1024.f); float s = 0.f;
#pragma unroll
                for (int bj = 0; bj < 2; ++bj) { const f32x4 v0 = acc[ai][bj][m][0] * r, v1 = acc[ai][bj][m][1] * r;
                    const f32x2 a = gelu_pk((f32x2){v0[0], v0[1]}), b = gelu_pk((f32x2){v0[2], v0[3]}), c = gelu_pk((f32x2){v1[0], v1[1]}), d = gelu_pk((f32x2){v1[2], v1[3]});
                    s += (a.x * a.x + a.y * a.y) + (b.x * b.x + b.y * b.y) + (c.x * c.x + c.y * c.y) + (d.x * d.x + d.y * d.y);
                    u32x4 w; w.x = cvtpk(a.x, a.y); w.y = cvtpk(b.x, b.y); w.z = cvtpk(c.x, c.y); w.w = cvtpk(d.x, d.y);
                    *(u32x4*)(Z + (size_t)row * 2048 + col0 + bj * HALF) = w; }
                if (u.pn >= 4) { s = red_fq(s); if (fq == 0) add_stat(ssv + row, s); } }
    }
};
struct EpiQL { static constexpr bool PERM = true, AFTER_DRAIN = false;
    bf16_t* QL; const float* ss; float* ssq;
    __device__ __forceinline__ void operator()(const f32x4 (&acc)[2][2][4][2], const Unit& u, int wr, int wc, int fr, int fq) const {
        const int row0 = u.pm * BM + wr * 64 + fr, col0 = wc * 32 + 8 * fq;
#pragma unroll
        for (int ai = 0; ai < 2; ++ai)
#pragma unroll
            for (int m = 0; m < 4; ++m) { const int row = row0 + ai * HALF + m * 16; const float r = rstd_of(ss, row, 1.f / 1024.f); float s = 0.f;
#pragma unroll
                for (int bj = 0; bj < 2; ++bj) { const f32x4 v0 = acc[ai][bj][m][0] * r, v1 = acc[ai][bj][m][1] * r;
                    s += (v0[0] * v0[0] + v0[1] * v0[1]) + (v0[2] * v0[2] + v0[3] * v0[3]) + (v1[0] * v1[0] + v1[1] * v1[1]) + (v1[2] * v1[2] + v1[3] * v1[3]);
                    u32x4 w; w.x = cvtpk(v0[0], v0[1]); w.y = cvtpk(v0[2], v0[3]); w.z = cvtpk(v1[0], v1[1]); w.w = cvtpk(v1[2], v1[3]);
                    *(u32x4*)(QL + (size_t)row * 256 + col0 + bj * HALF) = w; }
                s = red_fq(s); if (fq == 0) add_stat(ssq + row, s); }
    }
};
struct EpiQ { static constexpr bool PERM = true, AFTER_DRAIN = false;
    bf16_t* Q; const float* ssq; const float* rope; float qscale;
    __device__ __forceinline__ void operator()(const f32x4 (&acc)[2][2][4][2], const Unit& u, int wr, int wc, int fr, int fq) const {
        const int row0 = u.pm * BM + wr * 64 + fr, col0 = u.pn * BM + wc * 32 + 8 * fq; const int i0 = 8 * (fq & 1); const float sgn = fq < 2 ? -1.f : 1.f;
#pragma unroll
        for (int ai = 0; ai < 2; ++ai)
#pragma unroll
            for (int m = 0; m < 4; ++m) { const int row = row0 + ai * HALF + m * 16; const float r = rstd_of(ssq, row, 1.f / 256.f) * qscale;
                const int pos = row < 32768 ? (row & 8191) : 2048 + ((row - 32768) & 63);
#pragma unroll
                for (int bj = 0; bj < 2; ++bj) { const int grp = u.pn * 8 + bj * 4 + wc;
                    f32x4 a = acc[ai][bj][m][0] * r, b = acc[ai][bj][m][1] * r;
                    if (grp % 3 == 2) { f32x4 pa, pb;
#pragma unroll
                        for (int j = 0; j < 4; ++j) { pa[j] = __shfl_xor(a[j], 32); pb[j] = __shfl_xor(b[j], 32); }
                        const float* rp = rope + pos * 32 + i0;
                        const f32x4 c0 = *(const f32x4*)rp, c1 = *(const f32x4*)(rp + 4), s0 = *(const f32x4*)(rp + 16), s1 = *(const f32x4*)(rp + 20);
                        a = a * c0 + pa * s0 * sgn; b = b * c1 + pb * s1 * sgn; }
                    u32x4 w; w.x = cvtpk(a[0], a[1]); w.y = cvtpk(a[2], a[3]); w.z = cvtpk(b[0], b[1]); w.w = cvtpk(b[2], b[3]);
                    *(u32x4*)(Q + (size_t)row * 1536 + col0 + bj * HALF) = w; }
                asm volatile("" ::: "memory"); }
    }
};
struct EpiLat { static constexpr bool PERM = false, AFTER_DRAIN = false;
    float* KV; const float* ss; float* ssc;
    __device__ __forceinline__ void operator()(const f32x4 (&acc)[2][2][4][2], const Unit& u, int wr, int wc, int fr, int fq) const {
        const int row0 = u.pm * BM + wr * 64 + fr, col0 = wc * 32 + 4 * fq;
#pragma unroll
        for (int ai = 0; ai < 2; ++ai)
#pragma unroll
            for (int m = 0; m < 4; ++m) { const int row = row0 + ai * HALF + m * 16; const float r = rstd_of(ss, row, 1.f / 1024.f); float s = 0.f;
#pragma unroll
                for (int bj = 0; bj < 2; ++bj)
#pragma unroll
                    for (int n = 0; n < 2; ++n) { const int col = col0 + bj * HALF + n * 16;
                        if (col < 160) { const f32x4 v = acc[ai][bj][m][n] * r; *(f32x4*)(KV + (size_t)row * 160 + col) = v;
                            if (col < 128) s += (v[0] * v[0] + v[1] * v[1]) + (v[2] * v[2] + v[3] * v[3]); } }
                s = red_fq(s); if (fq == 0) add_stat(ssc + row, s); }
    }
};
template <int LDC> struct EpiPlain { static constexpr bool PERM = true, AFTER_DRAIN = false;
    bf16_t* O;
    __device__ __forceinline__ void operator()(const f32x4 (&acc)[2][2][4][2], const Unit& u, int wr, int wc, int fr, int fq) const {
        const int row0 = u.pm * BM + wr * 64 + fr, col0 = u.pn * BM + wc * 32 + 8 * fq;
#pragma unroll
        for (int ai = 0; ai < 2; ++ai)
#pragma unroll
            for (int m = 0; m < 4; ++m) { const int row = row0 + ai * HALF + m * 16;
#pragma unroll
                for (int bj = 0; bj < 2; ++bj) { const f32x4 v0 = acc[ai][bj][m][0], v1 = acc[ai][bj][m][1];
                    u32x4 w; w.x = cvtpk(v0[0], v0[1]); w.y = cvtpk(v0[2], v0[3]); w.z = cvtpk(v1[0], v1[1]); w.w = cvtpk(v1[2], v1[3]);
                    *(u32x4*)(O + (size_t)row * LDC + col0 + bj * HALF) = w; } }
    }
};
template <class Epi, class Sched, bool ALIGN_EPI = false, bool SP2 = false>
__device__ __forceinline__ void gemm_phase(PG8_LAS unsigned char* lds, const Gemm g, const Sched& S, const Epi& E) {
    const int tid = opaque_tid(), wid = __builtin_amdgcn_readfirstlane(tid >> 6), lane = tid & 63, wr = wid >> 2, wc = wid & 3, fr = lane & 15, fq = lane >> 4;
    const int K = g.K, nt = K / BK;
    unsigned voffA[2], voffB[2];
#pragma unroll
    for (int i = 0; i < 2; ++i) { int R, C; stage_rc(tid * 16 + i * 8192, R, C); const int Rb = Epi::PERM ? ((R & ~31) + perm32(R & 31)) : R;
        voffA[i] = (unsigned)(R * K + C) * 2u; voffB[i] = (unsigned)(Rb * K + C) * 2u; }
    const size_t kstep = (size_t)(BK * 2);
    const size_t hstep = (size_t)HALF * K * 2;
    const size_t tstep = 2 * hstep;
    const unsigned ldsw = (unsigned)wid * 1024u;
    const int aoff = lds_byte(wr * 64 + fr, fq * 8), boff = lds_byte(wc * 32 + fr, fq * 8);
#define PG8_SA(b, h) (((b) * 2 + (h)) * HTB)
#define PG8_SB(b, h) ((4 + (b) * 2 + (h)) * HTB)
#define PG8_STAGE(bufoff, gbase, voff) do { _Pragma("unroll") for (int _i = 0; _i < 2; ++_i) \
        __builtin_amdgcn_global_load_lds((const unsigned*)((const char*)(gbase) + (voff)[_i]), (PG8_LAS unsigned*)(lds + (bufoff) + ldsw + _i * 8192), 16, 0, 0); } while (0)
#define PG8_LDA(dst, b, h) do { _Pragma("unroll") for (int m = 0; m < 4; ++m) _Pragma("unroll") for (int k = 0; k < 2; ++k) dst[m][k] = *(const PG8_LAS bf16x8*)(lds + PG8_SA(b, h) + aoff + m * 2048 + k * 1024); } while (0)
#define PG8_LDB(dst, b, h) do { _Pragma("unroll") for (int n = 0; n < 2; ++n) _Pragma("unroll") for (int k = 0; k < 2; ++k) dst[n][k] = *(const PG8_LAS bf16x8*)(lds + PG8_SB(b, h) + boff + n * 2048 + k * 1024); } while (0)
#define PG8_MMA(ai, bj, At, Bt) do { __builtin_amdgcn_s_setprio(1); _Pragma("unroll") for (int m = 0; m < 4; ++m) _Pragma("unroll") for (int n = 0; n < 2; ++n) _Pragma("unroll") for (int k = 0; k < 2; ++k) \
        acc[ai][bj][m][n] = __builtin_amdgcn_mfma_f32_16x16x32_bf16(Bt[n][k], At[m][k], acc[ai][bj][m][n], 0, 0, 0); __builtin_amdgcn_s_setprio(0); } while (0)
#define PG8_WAIT_V(n) asm volatile("s_waitcnt vmcnt(" #n ")" ::: "memory")
#define PG8_WAIT_L(n) asm volatile("s_waitcnt lgkmcnt(" #n ")" ::: "memory")
#define PG8_BAR __builtin_amdgcn_s_barrier()
#define PG8_SCHED __builtin_amdgcn_sched_barrier(0)
    Unit cur, nxt; int ui = 0;
    if (!S.next(0, cur)) return;
    f32x4 acc[2][2][4][2];
#pragma unroll
    for (int a = 0; a < 2; ++a)
#pragma unroll
        for (int b = 0; b < 2; ++b)
#pragma unroll
            for (int m = 0; m < 4; ++m)
#pragma unroll
                for (int n = 0; n < 2; ++n) acc[a][b][m][n] = (f32x4){0.f, 0.f, 0.f, 0.f};
    bf16x8 At[4][2], B0[2][2], B1[2][2];
    const char* cA = (const char*)g.A + (size_t)cur.pm * tstep; const char* cB = (const char*)g.Bt + (size_t)cur.pn * tstep;
    S.a_ready(cur);
    if constexpr (SP2) {
        PG8_STAGE(PG8_SB(0, 0), cB, voffB); PG8_STAGE(PG8_SB(0, 1), cB + hstep, voffB); PG8_STAGE(PG8_SA(0, 0), cA, voffA); PG8_STAGE(PG8_SA(0, 1), cA + hstep, voffA);
        if (wr == 1) PG8_BAR;
        PG8_WAIT_V(2); PG8_BAR;
        PG8_STAGE(PG8_SB(1, 0), cB + kstep, voffB); PG8_STAGE(PG8_SA(1, 0), cA + kstep, voffA); PG8_STAGE(PG8_SB(1, 1), cB + hstep + kstep, voffB);
        PG8_WAIT_V(6); PG8_BAR;
    } else {
        PG8_STAGE(PG8_SB(0, 0), cB, voffB); PG8_STAGE(PG8_SA(0, 0), cA, voffA); PG8_STAGE(PG8_SB(0, 1), cB + hstep, voffB); PG8_STAGE(PG8_SA(0, 1), cA + hstep, voffA);
        if (wr == 1) PG8_BAR;
        PG8_WAIT_V(4); PG8_BAR;
        PG8_STAGE(PG8_SB(1, 0), cB + kstep, voffB); PG8_STAGE(PG8_SA(1, 0), cA + kstep, voffA); PG8_STAGE(PG8_SB(1, 1), cB + hstep + kstep, voffB);
        PG8_WAIT_V(6); PG8_BAR;
    }
    for (;;) {
        const bool has_next = S.next(ui + 1, nxt);
        const char* nA = has_next ? (const char*)g.A + (size_t)nxt.pm * tstep : cA; const char* nB = has_next ? (const char*)g.Bt + (size_t)nxt.pn * tstep : cB;
        for (int t = 0; t < nt; t += 2) {
            const bool last = (t == nt - 2);
            const char* a1 = cA + (size_t)(t + 1) * kstep;
            const char* a2 = last ? nA : cA + (size_t)(t + 2) * kstep; const char* b2 = last ? nB : cB + (size_t)(t + 2) * kstep;
            const char* a3 = a2 + kstep; const char* b3 = b2 + kstep;
            if (last && has_next) S.a_ready(nxt);
            if constexpr (SP2) {
            PG8_LDB(B0, 0, 0); PG8_LDB(B1, 0, 1); PG8_SCHED; PG8_LDA(At, 0, 0); PG8_STAGE(PG8_SA(1, 1), a1 + hstep, voffA);
            PG8_WAIT_V(8); PG8_WAIT_L(0); PG8_BAR; PG8_MMA(0, 0, At, B0); PG8_MMA(0, 1, At, B1); PG8_BAR; PG8_SCHED;
            PG8_LDA(At, 0, 1); PG8_STAGE(PG8_SB(0, 0), b2, voffB); PG8_STAGE(PG8_SB(0, 1), b2 + hstep, voffB); PG8_STAGE(PG8_SA(0, 0), a2, voffA);
            PG8_WAIT_V(8); PG8_WAIT_L(0); PG8_BAR; PG8_MMA(1, 0, At, B0); PG8_MMA(1, 1, At, B1); PG8_BAR; PG8_SCHED;
            PG8_LDB(B0, 1, 0); PG8_LDB(B1, 1, 1); PG8_SCHED; PG8_LDA(At, 1, 0); PG8_STAGE(PG8_SA(0, 1), a2 + hstep, voffA);
            PG8_WAIT_V(8); PG8_WAIT_L(0); PG8_BAR; PG8_MMA(0, 0, At, B0); PG8_MMA(0, 1, At, B1); PG8_BAR; PG8_SCHED;
            PG8_LDA(At, 1, 1); PG8_STAGE(PG8_SB(1, 0), b3, voffB); PG8_STAGE(PG8_SB(1, 1), b3 + hstep, voffB); PG8_STAGE(PG8_SA(1, 0), a3, voffA);
            PG8_WAIT_V(8); PG8_WAIT_L(0); PG8_BAR; PG8_MMA(1, 0, At, B0); PG8_MMA(1, 1, At, B1); PG8_BAR; PG8_SCHED;
            } else {
            PG8_LDB(B0, 0, 0); PG8_SCHED; PG8_LDA(At, 0, 0); PG8_STAGE(PG8_SA(1, 1), a1 + hstep, voffA);
            PG8_WAIT_L(8); PG8_BAR; PG8_WAIT_L(0); PG8_MMA(0, 0, At, B0); PG8_BAR; PG8_SCHED;
            PG8_LDB(B1, 0, 1); PG8_STAGE(PG8_SB(0, 0), b2, voffB);
            PG8_BAR; PG8_WAIT_L(0); PG8_MMA(0, 1, At, B1); PG8_BAR;
            PG8_LDA(At, 0, 1); PG8_STAGE(PG8_SA(0, 0), a2, voffA);
            PG8_BAR; PG8_WAIT_L(0); PG8_MMA(1, 0, At, B0); PG8_BAR; PG8_SCHED;
            PG8_STAGE(PG8_SB(0, 1), b2 + hstep, voffB);
            PG8_WAIT_V(6); PG8_BAR; PG8_MMA(1, 1, At, B1); PG8_BAR;
            PG8_LDB(B0, 1, 0); PG8_SCHED; PG8_LDA(At, 1, 0); PG8_STAGE(PG8_SA(0, 1), a2 + hstep, voffA);
            PG8_WAIT_L(8); PG8_BAR; PG8_WAIT_L(0); PG8_MMA(0, 0, At, B0); PG8_BAR; PG8_SCHED;
            PG8_LDB(B1, 1, 1); PG8_STAGE(PG8_SB(1, 0), b3, voffB);
            PG8_BAR; PG8_WAIT_L(0); PG8_MMA(0, 1, At, B1); PG8_BAR;
            PG8_LDA(At, 1, 1); PG8_STAGE(PG8_SA(1, 0), a3, voffA);
            PG8_BAR; PG8_WAIT_L(0); PG8_MMA(1, 0, At, B0); PG8_BAR; PG8_SCHED;
            PG8_STAGE(PG8_SB(1, 1), b3 + hstep, voffB);
            PG8_WAIT_V(6); PG8_BAR; PG8_MMA(1, 1, At, B1); PG8_BAR;
            }
        }
        if constexpr (ALIGN_EPI) { if (wr == 0) PG8_BAR; }
        if constexpr (!Epi::AFTER_DRAIN) { E(acc, cur, wr, wc, fr, fq); S.done(cur); }
        if (!has_next) break;
#pragma unroll
        for (int a = 0; a < 2; ++a)
#pragma unroll
            for (int b = 0; b < 2; ++b)
#pragma unroll
                for (int m = 0; m < 4; ++m)
#pragma unroll
                    for (int n = 0; n < 2; ++n) acc[a][b][m][n] = (f32x4){0.f, 0.f, 0.f, 0.f};
        cur = nxt; cA = nA; cB = nB; ++ui;
        if constexpr (ALIGN_EPI) { if (wr == 1) PG8_BAR; }
    }
    PG8_WAIT_V(0);
    if constexpr (!ALIGN_EPI) { if (wr == 0) PG8_BAR; }
    PG8_BAR;
    if constexpr (Epi::AFTER_DRAIN) { E.fused(acc, cur, wr, wc, fr, fq, lds, wid, lane); S.done(cur); }
#undef PG8_SA
#undef PG8_SB
#undef PG8_STAGE
#undef PG8_LDA
#undef PG8_LDB
#undef PG8_MMA
#undef PG8_WAIT_V
#undef PG8_WAIT_L
#undef PG8_BAR
#undef PG8_SCHED
}
}

constexpr int MP = 32768, MS = 512, MT = MP + MS, DM = 1024, DFF = 2816, NKV = 49664, SEQ = 8192, PAST = 2048, KVS = PAST + 64;
constexpr float EPS = 1e-6f;
constexpr float QSCALE = 0.10206207261596577f * 1.4426950408889634f;
#define GAS __attribute__((address_space(1)))
#define LAS __attribute__((address_space(3)))
typedef unsigned short bf16;
typedef float f32x4 __attribute__((ext_vector_type(4)));
typedef float f32x16 __attribute__((ext_vector_type(16)));
typedef short bf16x8 __attribute__((ext_vector_type(8)));
typedef short s16x4 __attribute__((ext_vector_type(4)));
typedef unsigned u32x4 __attribute__((ext_vector_type(4)));
typedef unsigned u32x2 __attribute__((ext_vector_type(2)));
using pg8::cvtpk;

constexpr size_t MiB = 1u << 20, KiB = 1u << 10;
constexpr size_t WS_STATS = 0;
constexpr size_t WS_BSG = 3 * MiB;
constexpr size_t WS_BAR = 3 * MiB + 512 * KiB;
constexpr size_t WS_SUB = WS_BAR + 16 * KiB;
constexpr size_t WS_ROPE = 4 * MiB;
constexpr size_t WS_WIN = 5 * MiB;
constexpr size_t WS_WOUT = 13 * MiB;
constexpr size_t WS_WM = 17 * MiB;
constexpr size_t WS_WDKV = 18 * MiB;
constexpr size_t WS_WUK = 18 * MiB + 512 * KiB;
constexpr size_t WS_WUV = 18 * MiB + 768 * KiB;
constexpr size_t WS_WDQ = 19 * MiB;
constexpr size_t WS_WUQ = 20 * MiB;
constexpr size_t WS_WO = 21 * MiB + 512 * KiB;
constexpr size_t WS_WGU1 = 26 * MiB, WS_WD1 = 37 * MiB, WS_WGU2 = 42 * MiB + 512 * KiB, WS_WD2 = 53 * MiB + 512 * KiB;
constexpr size_t WS_HB = 59 * MiB;
constexpr size_t WS_SCR = 124 * MiB;
constexpr size_t WS_KN = 303 * MiB;
constexpr size_t WS_VT = 400 * MiB;
constexpr size_t WS_KR = 497 * MiB;
constexpr size_t WS_END = 501 * MiB;
constexpr size_t SCR_CKVALL = 32 * MiB, SCR_O = (size_t)MT * 1536 * 2, SCR_QL = SCR_O + (size_t)MT * 1024 * 2;
static_assert(SCR_QL + (size_t)MT * 256 * 2 <= 179 * MiB, "scratch");
constexpr size_t OUT_Y = 0, OUT_CKVP = (size_t)MT * DM, OUT_KRP = OUT_CKVP + (size_t)MP * 128, OUT_CKVS = OUT_KRP + (size_t)MP * 32, OUT_KRS = OUT_CKVS + (size_t)MS * 128,
                 OUT_AV = OUT_KRS + (size_t)MS * 32, OUT_END = OUT_AV + (size_t)2 * MS * 1024;

constexpr int LDS_BYTES = 147456;
constexpr int NWAVES = 8;
#ifndef REP_ATT
#define REP_ATT 1
#endif
#ifndef REP_CONV
#define REP_CONV 1
#endif
#ifndef REP_OTH
#define REP_OTH 1
#endif
#ifndef REP_PRO
#define REP_PRO 1
#endif
#ifndef REP_RES
#define REP_RES 1
#endif
#ifndef REP_GU
#define REP_GU 1
#endif
#define LDS_WAIT() asm volatile("s_waitcnt lgkmcnt(0)" ::: "memory")
constexpr int XB_LDS_OFF = 147456 - 64;
constexpr int PTR_OFF = 131072;
__device__ __forceinline__ const void* ldptr(LAS unsigned char* lds, int i) { const volatile LAS unsigned* p = (const volatile LAS unsigned*)(lds + PTR_OFF) + 2 * i; const unsigned lo = __builtin_amdgcn_readfirstlane(p[0]), hi = __builtin_amdgcn_readfirstlane(p[1]); return (const void*)(((unsigned long long)hi << 32) | lo); }

struct Args { const float* in[26]; float* out; unsigned char* ws; int ph_lo, ph_hi; };
enum { I_XP = 0, I_XS, I_CCKV, I_CKR, I_F1N, I_F1GU, I_F1D, I_MIXN, I_F2N, I_F2GU, I_F2D, I_AWIN, I_AVN, I_AWS, I_ABS, I_AWOUT, I_KVN, I_WDKV, I_CKVN, I_WUK, I_WUV, I_BWDQ, I_BQN, I_BWUQ, I_BWO, I_FN };

__device__ __forceinline__ float wave_sum(float v) {
#pragma unroll
    for (int o = 1; o < 64; o <<= 1) v += __shfl_xor(v, o);
    return v;
}

__device__ __forceinline__ void tr_item(const float* W, int N, bf16* WT, int ldk, const float* gain, LAS float* scr, int k0, int n0, int drow0, int lane) {
#pragma unroll 8
    for (int i = 0; i < 32; ++i) { const int kk = 2 * i + (lane >> 5); float w = W[(size_t)(k0 + kk) * N + n0 + (lane & 31)]; if (gain) w *= gain[k0 + kk]; scr[kk * 33 + (lane & 31)] = w; }
    LDS_WAIT(); asm volatile("" ::: "memory");
    const int c = lane & 7;
#pragma unroll
    for (int j = 0; j < 4; ++j) { const int n = (lane >> 3) + 8 * j; const LAS float* s = scr + (8 * c) * 33 + n;
        u32x4 o; o.x = cvtpk(s[0 * 33], s[1 * 33]); o.y = cvtpk(s[2 * 33], s[3 * 33]); o.z = cvtpk(s[4 * 33], s[5 * 33]); o.w = cvtpk(s[6 * 33], s[7 * 33]);
        *(u32x4*)(WT + (size_t)(drow0 + n) * ldk + k0 + 8 * c) = o; }
    LDS_WAIT(); asm volatile("" ::: "memory");
}
__device__ __forceinline__ void tr_item64(const float* W, int N, bf16* WT, int ldk, const float* gain, LAS float* scr, int k0, int n0, int drow0, int lane) {
    const int rr = lane >> 4, c4 = lane & 15;
    f32x4 v[16];
#pragma unroll
    for (int i = 0; i < 16; ++i) v[i] = *(const f32x4*)(W + (size_t)(k0 + 4 * i + rr) * N + n0 + 4 * c4);
#pragma unroll
    for (int i = 0; i < 16; ++i) { const int row = 4 * i + rr; const float g = gain ? gain[k0 + row] : 1.f; LAS float* s = scr + row * 65 + 4 * c4;
        s[0] = v[i][0] * g; s[1] = v[i][1] * g; s[2] = v[i][2] * g; s[3] = v[i][3] * g; }
    LDS_WAIT(); asm volatile("" ::: "memory");
    const int nl = lane >> 3, kc = lane & 7;
#pragma unroll
    for (int j = 0; j < 8; ++j) { const int n = nl + 8 * j; const LAS float* s = scr + (8 * kc) * 65 + n;
        u32x4 o; o.x = cvtpk(s[0 * 65], s[1 * 65]); o.y = cvtpk(s[2 * 65], s[3 * 65]); o.z = cvtpk(s[4 * 65], s[5 * 65]); o.w = cvtpk(s[6 * 65], s[7 * 65]);
        *(u32x4*)(WT + (size_t)(drow0 + n) * ldk + k0 + 8 * kc) = o; }
    LDS_WAIT(); asm volatile("" ::: "memory");
}
__device__ __forceinline__ void conv_job(const float* W, int K, int N, bf16* WT, const float* gain, bool gu, LAS float* scr, int gw, int NGW, int lane, int& base) {
    const bool wide = (N & 63) == 0; const int bn = wide ? 64 : 32;
    const int nnb = N / bn, nitems = (K / 64) * nnb;
    int first = (gw - (base % NGW) + NGW) % NGW;
    for (int it = first; it < nitems; it += NGW) { const int kb = it / nnb, nb = it % nnb, n0 = bn * nb;
        int drow0 = n0;
        if (gu) { const int j = n0 < DFF ? n0 : n0 - DFF; drow0 = (j >> 7) * 256 + (j & 127) + (n0 < DFF ? 0 : 128); }
        if (wide) tr_item64(W, N, WT, K, gain, scr, 64 * kb, n0, drow0, lane); else tr_item(W, N, WT, K, gain, scr, 64 * kb, n0, drow0, lane); }
    base += nitems;
}

namespace att {
constexpr int KROW = 208, VROW = 136, KBUF = 64 * KROW, VBUF = 64 * VROW, K_OFF = 0, V_OFF = 2 * KBUF, WS_OFF = V_OFF + 2 * VBUF;
#define MFMA32(a, b, c) __builtin_amdgcn_mfma_f32_32x32x16_bf16((a), (b), (c), 0, 0, 0)
__device__ __forceinline__ void unit(LAS unsigned char* lds, const bf16* __restrict__ Q, const bf16* __restrict__ KN, const bf16* __restrict__ KR, const bf16* __restrict__ VT, bf16* __restrict__ O,
                                     int qrow0, int kvbase, int NT, int tmax, int h) {
    const int tid = opaque_tid(), lane = tid & 63, r32 = lane & 31, hi = lane >> 5; const int wid = __builtin_amdgcn_readfirstlane(tid >> 6);
    const bool active = tmax >= 0;
    const int r0 = tid / 12, c0 = tid % 12, e1 = 512 + tid, r1 = e1 / 12, c1 = e1 % 12; const bool has1 = tid < 256;
    const bf16* s0 = c0 < 8 ? KN + (size_t)(kvbase + r0) * 1024 + h * 64 + c0 * 8 : KR + (size_t)(kvbase + r0) * 32 + (c0 - 8) * 8; const size_t st0 = c0 < 8 ? 64 * 1024 : 64 * 32;
    const bf16* s1 = c1 < 8 ? KN + (size_t)(kvbase + r1) * 1024 + h * 64 + c1 * 8 : KR + (size_t)(kvbase + r1) * 32 + (c1 - 8) * 8; const size_t st1 = c1 < 8 ? 64 * 1024 : 64 * 32;
    const int vd = tid >> 3, vc = tid & 7;
    const bf16* sv = VT + (size_t)(h * 64 + vd) * NKV + kvbase + vc * 8;
    const int kd0 = K_OFF + r0 * KROW + c0 * 16, kd1 = K_OFF + r1 * KROW + c1 * 16, vdst = V_OFF + vd * VROW + vc * 16;
    bf16x8 qr[6];
    const int qrow = qrow0 + 32 * (active ? wid : 0) + r32;
#pragma unroll
    for (int d0 = 0; d0 < 6; ++d0) qr[d0] = *(const bf16x8*)(Q + (size_t)qrow * 1536 + h * 96 + d0 * 16 + hi * 8);
    float mref = 0.f, lrun = 0.f; f32x16 o0 = {}, o1 = {}, negm = {};
    u32x4 k0v = *(const u32x4*)s0, k1v = has1 ? *(const u32x4*)s1 : (u32x4){0u, 0u, 0u, 0u}, vv = *(const u32x4*)sv;
    u32x4 k0w = k0v, k1w = k1v, vw = vv;
    if (NT > 1) { k0w = *(const u32x4*)(s0 + st0); if (has1) k1w = *(const u32x4*)(s1 + st1); vw = *(const u32x4*)(sv + 64); }
    *(LAS u32x4*)(lds + kd0) = k0v; if (has1) *(LAS u32x4*)(lds + kd1) = k1v; *(LAS u32x4*)(lds + vdst) = vv;
    k0v = k0w; k1v = k1w; vv = vw;
    __syncthreads();
    LAS float* wsf = (LAS float*)(lds + WS_OFF) + wid * 32;
    for (int t = 0; t < NT; ++t) {
        const int cur = t & 1; const bool more = t + 1 < NT;
        if (t + 2 < NT) { k0w = *(const u32x4*)(s0 + (size_t)(t + 2) * st0); if (has1) k1w = *(const u32x4*)(s1 + (size_t)(t + 2) * st1); vw = *(const u32x4*)(sv + (size_t)(t + 2) * 64); }
        if (t <= tmax) {
            const LAS unsigned char* Kb = lds + K_OFF + cur * KBUF + r32 * KROW + hi * 16; const LAS unsigned char* Vb = lds + V_OFF + cur * VBUF + r32 * VROW + hi * 8;
            bf16x8 kf[12];
#pragma unroll
            for (int d0 = 0; d0 < 6; ++d0) { kf[2 * d0] = *(const LAS bf16x8*)(Kb + d0 * 32); kf[2 * d0 + 1] = *(const LAS bf16x8*)(Kb + 32 * KROW + d0 * 32); }
            __builtin_amdgcn_sched_barrier(0);
            f32x16 p0 = MFMA32(kf[0], qr[0], negm), p1 = MFMA32(kf[1], qr[0], negm);
#pragma unroll
            for (int d0 = 1; d0 < 6; ++d0) { p0 = MFMA32(kf[2 * d0], qr[d0], p0); p1 = MFMA32(kf[2 * d0 + 1], qr[d0], p1); }
            s16x4 vl0[4], vh0[4], vl1[4], vh1[4];
#pragma unroll
            for (int ks = 0; ks < 4; ++ks) { vl0[ks] = *(const LAS s16x4*)(Vb + ks * 32); vh0[ks] = *(const LAS s16x4*)(Vb + ks * 32 + 16);
                vl1[ks] = *(const LAS s16x4*)(Vb + 32 * VROW + ks * 32); vh1[ks] = *(const LAS s16x4*)(Vb + 32 * VROW + ks * 32 + 16); }
            __builtin_amdgcn_sched_barrier(0);
            float ma = __builtin_fmaxf(__builtin_fmaxf(p0[0], p0[1]), p1[0]), mb = __builtin_fmaxf(__builtin_fmaxf(p0[2], p0[3]), p1[1]);
            ma = __builtin_fmaxf(__builtin_fmaxf(ma, p1[2]), p1[3]);
#pragma unroll
            for (int i = 4; i < 16; i += 4) { ma = __builtin_fmaxf(__builtin_fmaxf(ma, p0[i]), p0[i + 1]); mb = __builtin_fmaxf(__builtin_fmaxf(mb, p0[i + 2]), p0[i + 3]);
                ma = __builtin_fmaxf(__builtin_fmaxf(ma, p1[i]), p1[i + 1]); mb = __builtin_fmaxf(__builtin_fmaxf(mb, p1[i + 2]), p1[i + 3]); }
            float mx = __builtin_fmaxf(ma, mb); mx = __builtin_fmaxf(mx, __shfl_xor(mx, 32));
            if (t == 0 || __any(mx > 8.0f)) {
                const float dl = t == 0 ? mx : __builtin_fmaxf(mx, 0.f); mref += dl;
#pragma unroll
                for (int i = 0; i < 16; ++i) { p0[i] -= dl; p1[i] -= dl; negm[i] = -mref; }
                if (t != 0) { const float fsc = __builtin_amdgcn_exp2f(-dl); lrun *= fsc;
                    if (hi == 0) wsf[r32] = fsc;
#pragma unroll
                    for (int g = 0; g < 4; ++g) { const f32x4 a = *(const LAS f32x4*)(wsf + 8 * g + 4 * hi);
#pragma unroll
                        for (int j = 0; j < 4; ++j) { o0[4 * g + j] *= a[j]; o1[4 * g + j] *= a[j]; } } }
            }
            typedef float f32x2v __attribute__((ext_vector_type(2)));
            f32x2v rs2 = {0.f, 0.f};
#pragma unroll
            for (int i = 0; i < 16; ++i) { p0[i] = __builtin_amdgcn_exp2f(p0[i]); p1[i] = __builtin_amdgcn_exp2f(p1[i]); }
#pragma unroll
            for (int i = 0; i < 16; i += 2) { rs2 += (f32x2v){p0[i], p0[i + 1]}; rs2 += (f32x2v){p1[i], p1[i + 1]}; }
            lrun += rs2.x + rs2.y;
            bf16x8 pa[4];
#pragma unroll
            for (int s = 0; s < 2; ++s) { u32x4 w0, w1;
                w0.x = cvtpk(p0[8 * s + 0], p0[8 * s + 1]); w0.y = cvtpk(p0[8 * s + 2], p0[8 * s + 3]); w0.z = cvtpk(p0[8 * s + 4], p0[8 * s + 5]); w0.w = cvtpk(p0[8 * s + 6], p0[8 * s + 7]);
                w1.x = cvtpk(p1[8 * s + 0], p1[8 * s + 1]); w1.y = cvtpk(p1[8 * s + 2], p1[8 * s + 3]); w1.z = cvtpk(p1[8 * s + 4], p1[8 * s + 5]); w1.w = cvtpk(p1[8 * s + 6], p1[8 * s + 7]);
                pa[s] = __builtin_bit_cast(bf16x8, w0); pa[2 + s] = __builtin_bit_cast(bf16x8, w1); }
#pragma unroll
            for (int ks = 0; ks < 4; ++ks) {
                const s16x4 l0 = vl0[ks], h0 = vh0[ks], l1 = vl1[ks], h1 = vh1[ks];
                const bf16x8 v0 = {l0[0], l0[1], l0[2], l0[3], h0[0], h0[1], h0[2], h0[3]}, v1 = {l1[0], l1[1], l1[2], l1[3], h1[0], h1[1], h1[2], h1[3]};
                o0 = MFMA32(pa[ks], v0, o0); o1 = MFMA32(pa[ks], v1, o1); }
        }
        if (more) { const int nb = cur ^ 1; *(LAS u32x4*)(lds + kd0 + nb * KBUF) = k0v; if (has1) *(LAS u32x4*)(lds + kd1 + nb * KBUF) = k1v; *(LAS u32x4*)(lds + vdst + nb * VBUF) = vv; }
        k0v = k0w; k1v = k1w; vv = vw;
        __syncthreads();
    }
    if (active) {
        lrun += __shfl_xor(lrun, 32);
        if (hi == 0) wsf[r32] = 1.f / lrun;
        bf16* Ow = O + (size_t)(qrow0 + 32 * wid) * 1024 + h * 64 + r32;
#pragma unroll
        for (int g = 0; g < 4; ++g) { const f32x4 inv = *(const LAS f32x4*)(wsf + 8 * g + 4 * hi);
#pragma unroll
            for (int j = 0; j < 4; ++j) { const int row = 8 * g + 4 * hi + j; const unsigned w = cvtpk(o0[4 * g + j] * inv[j], o1[4 * g + j] * inv[j]);
                Ow[(size_t)row * 1024] = (bf16)(w & 0xffffu); Ow[(size_t)row * 1024 + 32] = (bf16)(w >> 16); } }
    }
}
__device__ __forceinline__ void phase(LAS unsigned char* lds, const bf16* Q, const bf16* KN, const bf16* KR, const bf16* VT, bf16* O, int vcu, int G) {
    const int wid = __builtin_amdgcn_readfirstlane((int)threadIdx.x >> 6);
    for (int p = vcu; p < 1024 + 128; p += G) {
        const int nsub = p < 1024 ? 2 : 1;
        for (int sub = 0; sub < nsub; ++sub) {
            int qrow0, kvbase, NT, tmax, h;
            if (p < 1024) { const int bh = p >> 4, pp = p & 15, b = bh >> 4, qb = sub ? pp : 31 - pp; h = bh & 15; qrow0 = b * SEQ + qb * 256; kvbase = b * SEQ; NT = 4 * qb + 4; tmax = 4 * qb + (wid >> 1); }
            else { const int su = p - 1024, sb = su >> 4; h = su & 15; qrow0 = MP + sb * 64; kvbase = MP + sb * KVS; NT = KVS / 64; tmax = wid < 2 ? NT - 1 : -1; }
            unit(lds, Q, KN, KR, VT, O, qrow0, kvbase, NT, tmax, h);
        }
    }
}
}

namespace sg {
constexpr int VTROW = 272;
__device__ __forceinline__ void phase(LAS unsigned char* lds, const bf16* Z, bf16* P, const float* ssv, const float* vgain  , const bf16* Wm  , const float* bsg  ,
                                      float* av_out  , int vcu, int G) {
    const int tid = opaque_tid(), lane = tid & 63, fr = lane & 15, fq = lane >> 4; const int wid = __builtin_amdgcn_readfirstlane(tid >> 6);
    for (int un = vcu; un < (MT / 128) * 8; un += G) {
        const int blk = un >> 3, g = un & 7, r0 = blk * 128; const int typ = blk >= MP / 128 ? 1 : 0;
#pragma unroll
        for (int i = 0; i < 4; ++i) { const int e = tid + 512 * i, s = e >> 4, c8 = e & 15; const int row = r0 + s;
            const u32x4 raw = *(const u32x4*)(Z + (size_t)row * 2048 + 1024 + g * 128 + c8 * 8);
            const float r = __builtin_amdgcn_rsqf(pg8::ld_stat(ssv + row) * (1.f / 1024.f) + EPS);
            const f32x4 g0 = *(const f32x4*)(vgain + g * 128 + c8 * 8), g1 = *(const f32x4*)(vgain + g * 128 + c8 * 8 + 4);
            float v[8];
#pragma unroll
            for (int j = 0; j < 4; ++j) { const unsigned w = raw[j]; v[2 * j] = __uint_as_float(w << 16); v[2 * j + 1] = __uint_as_float(w & 0xffff0000u); }
#pragma unroll
            for (int j = 0; j < 4; ++j) { v[j] *= r * g0[j]; v[4 + j] *= r * g1[j]; }
            if (typ) { float* ap = av_out + (size_t)(row - MP) * 1024 + g * 128 + c8 * 8; *(f32x4*)ap = (f32x4){v[0], v[1], v[2], v[3]}; *(f32x4*)(ap + 4) = (f32x4){v[4], v[5], v[6], v[7]}; }
#pragma unroll
            for (int j = 0; j < 4; ++j) { const unsigned w = cvtpk(v[2 * j], v[2 * j + 1]);
                *(LAS bf16*)(lds + (c8 * 8 + 2 * j) * VTROW + s * 2) = (bf16)(w & 0xffffu); *(LAS bf16*)(lds + (c8 * 8 + 2 * j + 1) * VTROW + s * 2) = (bf16)(w >> 16); }
        }
        __syncthreads();
        const bf16* W = Wm + ((size_t)(typ * 8 + g) * 128 + 16 * wid + fr) * 128 + 8 * fq;
        f32x4 acc[8];
#pragma unroll
        for (int n = 0; n < 8; ++n) acc[n] = (f32x4){0.f, 0.f, 0.f, 0.f};
#pragma unroll
        for (int k = 0; k < 4; ++k) {
            if (32 * k <= 16 * wid + 15) {
                const bf16x8 wf = *(const bf16x8*)(W + 32 * k);
#pragma unroll
                for (int n = 0; n < 8; ++n) { const bf16x8 vf = *(const LAS bf16x8*)(lds + (16 * n + fr) * VTROW + (32 * k + 8 * fq) * 2);
                    acc[n] = __builtin_amdgcn_mfma_f32_16x16x32_bf16(vf, wf, acc[n], 0, 0, 0); }
            }
        }
        const int t = 16 * wid + fr, row = r0 + t; const float bias = bsg[(typ * 8 + g) * 128 + t];
#pragma unroll
        for (int n = 0; n < 8; ++n) { const size_t col = (size_t)g * 128 + 16 * n + 4 * fq;
            const u32x2 ur = *(const u32x2*)(Z + (size_t)row * 2048 + col);
            const float u0 = __uint_as_float(ur.x << 16), u1 = __uint_as_float(ur.x & 0xffff0000u), u2 = __uint_as_float(ur.y << 16), u3 = __uint_as_float(ur.y & 0xffff0000u);
            u32x2 w; w.x = cvtpk(u0 * (acc[n][0] + bias), u1 * (acc[n][1] + bias)); w.y = cvtpk(u2 * (acc[n][2] + bias), u3 * (acc[n][3] + bias));
            *(u32x2*)(P + (size_t)row * 1024 + col) = w; }
        __syncthreads();
    }
}
}

typedef GAS unsigned gu32;
#define XB_TMO      128
#define XB_XCNT(j)  (256  + 64 * (j))
#define XB_XSUB(j)  (1280 + 64 * (j))
#define XB_XGEN(j)  (2304 + 64 * (j))
#define XB_TOP      3328
#define XB_TOPGEN   3392
#define XCD_BAR_WORDS 3456
#define XB_SPIN_CAP (1u << 18)

__device__ __forceinline__ unsigned xb_ld(unsigned* p)              { return __hip_atomic_load(p, __ATOMIC_RELAXED, __HIP_MEMORY_SCOPE_AGENT); }
__device__ __forceinline__ unsigned xb_add(unsigned* p, unsigned v) { return __hip_atomic_fetch_add(p, v, __ATOMIC_RELAXED, __HIP_MEMORY_SCOPE_AGENT); }
__device__ __forceinline__ unsigned xb_xcc_id() { return (unsigned)__builtin_amdgcn_s_getreg((3 << 11) | 20) & 0xFu; }
#define XB_SPIN(cond, bar) do { unsigned _sp = 0; while (cond) { __builtin_amdgcn_s_sleep(1); \
    if ((++_sp & 255u) == 0u) { if (xb_ld(&(bar)[XB_TMO])) break; if (_sp > XB_SPIN_CAP) { atomicAdd(&(bar)[XB_TMO], 1u); break; } } } } while (0)

struct XcdBarrier {
    unsigned* bar; unsigned x;
    volatile LAS unsigned* st;
};

__device__ __forceinline__ XcdBarrier xcd_barrier_post(unsigned* bar, volatile LAS unsigned* st) {
    XcdBarrier b; b.bar = bar; b.x = xb_xcc_id(); b.st = st;
    if (threadIdx.x == 0) (void)xb_add(&bar[XB_XCNT(b.x)], 1u);
    return b;
}
__device__ __forceinline__ void xcd_barrier_complete(unsigned* bar, unsigned x, unsigned& nloc, unsigned& nx) {
    const unsigned G = gridDim.x * gridDim.y * gridDim.z;
    unsigned sum, cnt, mine, sp = 0u;
    for (;;) {
        sum = 0u; cnt = 0u; mine = 0u;
#pragma unroll
        for (unsigned j = 0; j < 16; ++j) { const unsigned c = xb_ld(&bar[XB_XCNT(j)]); sum += c; cnt += (c > 0u) ? 1u : 0u; mine = (j == x) ? c : mine; }
        if (sum == G) break;
        __builtin_amdgcn_s_sleep(1);
        if ((++sp & 255u) == 0u) { if (xb_ld(&bar[XB_TMO])) break; if (sp > XB_SPIN_CAP) { atomicAdd(&bar[XB_TMO], 1u); break; } }
    }
    nloc = mine > 0u ? mine : 1u; nx = cnt > 0u ? cnt : 1u;
}

__device__ __forceinline__ void xcd_barrier(const XcdBarrier& b) {
    asm volatile("s_waitcnt vmcnt(0)" ::: "memory");
    __syncthreads();
    if (threadIdx.x == 0) {
        unsigned* bar = b.bar;
        __builtin_amdgcn_s_waitcnt(0);
        unsigned nloc = b.st[0], nx = b.st[1];
        if (nloc == 0u) { xcd_barrier_complete(bar, b.x, nloc, nx); b.st[0] = nloc; b.st[1] = nx; }
        const unsigned old = xb_add(&bar[XB_XSUB(b.x)], 1u);
        const unsigned gen = old / nloc;
        if (old + 1u == (gen + 1u) * nloc) {
            __builtin_amdgcn_fence(__ATOMIC_RELEASE, "agent");
            asm volatile("s_waitcnt vmcnt(0)" ::: "memory");
            const unsigned og = xb_add(&bar[XB_TOP], 1u);
            const unsigned tg = og / nx;
            if (og + 1u == (tg + 1u) * nx) xb_add(&bar[XB_TOPGEN], 1u);
            else XB_SPIN(xb_ld(&bar[XB_TOPGEN]) == tg, bar);
            __builtin_amdgcn_fence(__ATOMIC_ACQUIRE, "agent");
            xb_add(&bar[XB_XGEN(b.x)], 1u);
            asm volatile("s_waitcnt vmcnt(0)" ::: "memory");
        } else {
            XB_SPIN(xb_ld(&bar[XB_XGEN(b.x)]) == gen, bar);
            __builtin_amdgcn_fence(__ATOMIC_ACQUIRE, "agent");
            asm volatile("s_waitcnt vmcnt(0)" ::: "memory");
        }
    }
    __syncthreads();
}

__device__ __forceinline__ void subset_sync(unsigned* cnt, unsigned target, bool wait) {
    asm volatile("s_waitcnt vmcnt(0)" ::: "memory");
    __syncthreads();
    if (threadIdx.x == 0) {
        __builtin_amdgcn_fence(__ATOMIC_RELEASE, "agent");
        asm volatile("s_waitcnt vmcnt(0)" ::: "memory");
        (void)__hip_atomic_fetch_add(cnt, 1u, __ATOMIC_RELAXED, __HIP_MEMORY_SCOPE_AGENT);
        if (wait) { unsigned sp = 0;
            while (__hip_atomic_load(cnt, __ATOMIC_RELAXED, __HIP_MEMORY_SCOPE_AGENT) < target) { __builtin_amdgcn_s_sleep(2); if (++sp > (1u << 22)) break; }
            __builtin_amdgcn_fence(__ATOMIC_ACQUIRE, "agent");
            asm volatile("s_waitcnt vmcnt(0)" ::: "memory"); }
    }
    __syncthreads();
}
__global__ void __launch_bounds__(NWAVES * 64, 2) mk_fwd(Args args) {
    extern __shared__ __attribute__((aligned(16))) unsigned char lds_raw[];
    LAS unsigned char* lds = (LAS unsigned char*)lds_raw;
    cg::grid_group grid = cg::this_grid();
#define wave (__builtin_amdgcn_readfirstlane((int)threadIdx.x >> 6))
#define TIDLANE() const int tid = opaque_tid(), lane = tid & 63; (void)tid; (void)lane
#define G ((int)gridDim.x)
#define bx ((int)blockIdx.x)
#define vcu ((G % 8 == 0) ? (bx % 8) * (G / 8) + bx / 8 : bx)
#define gw (vcu * NWAVES + wave)
#define NGW (G * NWAVES)
#define ARGP() const __attribute__((address_space(4))) Args* ap = (const __attribute__((address_space(4))) Args*)__builtin_amdgcn_kernarg_segment_ptr(); asm volatile("" : "+s"(ap))
#define IN(i) (ap->in[(i)])
#define OUTP (ap->out)
#define WS (ap->ws)
#define stats ((float*)(WS + WS_STATS))
#define SH(k) (stats + (size_t)(k) * MT)
#define SV(l) (stats + (size_t)(13 + (l)) * MT)
#define SQ(j) (stats + (size_t)(15 + (j)) * MT)
#define SC() (stats + (size_t)17 * MT)
#define HRES (OUTP + OUT_Y)
#define hb ((bf16*)(WS + WS_HB))
#define scr (WS + WS_SCR)
#define HID ((bf16*)scr)
#define Zb ((bf16*)scr)
#define Pb ((bf16*)(WS + WS_KN))
#define KVRAW ((float*)scr)
#define CKVALL ((bf16*)(scr + SCR_CKVALL))
#define Qb ((bf16*)scr)
#define Ob ((bf16*)(scr + SCR_O))
#define QLb ((bf16*)(scr + SCR_QL))
#define KNb ((bf16*)(WS + WS_KN))
#define VTb ((bf16*)(WS + WS_VT))
#define KRb ((bf16*)(WS + WS_KR))
#define rope ((const float*)(WS + WS_ROPE))
#define cscr ((LAS float*)(lds + wave * 16640))
#define RUN true
    if (threadIdx.x < 2) ((volatile LAS unsigned*)(lds + XB_LDS_OFF))[threadIdx.x] = 0u;
    __syncthreads();
    XcdBarrier xbar = xcd_barrier_post((unsigned*)(args.ws + WS_BAR), (volatile LAS unsigned*)(lds + XB_LDS_OFF));
#define SEAM() xcd_barrier(xbar)

    for (int rep = 0; rep < REP_PRO; ++rep) { ARGP(); TIDLANE(); if (rep) grid.sync();
        for (size_t i = (size_t)MT + (size_t)bx * 512 + tid; i < (size_t)18 * MT; i += (size_t)G * 512) stats[i] = 0.f;
        for (int m = gw; m < MT; m += NGW) { const float* xr = m < MP ? IN(I_XP) + (size_t)m * DM : IN(I_XS) + (size_t)(m - MP) * DM;
            float s = 0.f;
#pragma unroll
            for (int j = 0; j < 4; ++j) { const f32x4 v = *(const f32x4*)(xr + 256 * j + 4 * lane); if (G != 256) *(f32x4*)(HRES + (size_t)m * DM + 256 * j + 4 * lane) = v;
                u32x2 w; w.x = cvtpk(v[0], v[1]); w.y = cvtpk(v[2], v[3]); *(u32x2*)(hb + (size_t)m * DM + 256 * j + 4 * lane) = w;
                s += (v[0] * v[0] + v[1] * v[1]) + (v[2] * v[2] + v[3] * v[3]); }
            s = wave_sum(s); if (lane == 0) SH(0)[m] = s; }
        for (int i = bx * 512 + tid; i < SEQ * 16; i += G * 512) { const int pos = i >> 4, k = i & 15; const float inv = 1.0f / powf(10000.0f, (float)k * (2.0f / 32.0f)); const float ang = (float)pos * inv;
            ((float*)(WS + WS_ROPE))[pos * 32 + k] = cosf(ang); ((float*)(WS + WS_ROPE))[pos * 32 + 16 + k] = sinf(ang); }
        for (int i = bx * 512 + tid; i < 2 * 2 * 8 * 128 * 128; i += G * 512) { const int s = i & 127, t = (i >> 7) & 127, g = (i >> 14) & 7, typ = (i >> 17) & 1, l = i >> 18;
            float w = 0.f;
            if (typ == 0) { if (s <= t) w = IN(I_AWS)[(((size_t)l * 8 + g) * 128 + t) * 128 + s]; }
            else { if ((s >> 6) == (t >> 6) && (s & 63) <= (t & 63)) w = IN(I_AWS)[(((size_t)l * 8 + g) * 128 + (t & 63)) * 128 + (s & 63)]; }
            ((bf16*)(WS + WS_WM))[i] = (bf16)(cvtpk(w, 0.f) & 0xffffu); }
        for (int i = bx * 512 + tid; i < 2 * 2 * 8 * 128; i += G * 512) { const int t = i & 127, g = (i >> 7) & 7, typ = (i >> 10) & 1, l = i >> 11;
            ((float*)(WS + WS_BSG))[i] = IN(I_ABS)[((size_t)l * 8 + g) * 128 + (typ ? (t & 63) : t)]; }
        for (int i = bx * 512 + tid; i < 96 * 1024 / 8; i += G * 512) ((u32x4*)(WS + WS_WDKV + (size_t)160 * 1024 * 2))[i] = (u32x4){0u, 0u, 0u, 0u};
        int base = 0;
        for (int l = 0; l < 2; ++l) {
            conv_job(IN(I_AWIN) + (size_t)l * 1024 * 2048, 1024, 2048, (bf16*)(WS + WS_WIN + (size_t)l * 4 * MiB), IN(I_MIXN) + l * 1024, false, cscr, gw, NGW, lane, base);
            conv_job(IN(I_AWOUT) + (size_t)l * 1024 * 1024, 1024, 1024, (bf16*)(WS + WS_WOUT + (size_t)l * 2 * MiB), nullptr, false, cscr, gw, NGW, lane, base);
            conv_job(IN(I_BWDQ) + (size_t)l * 1024 * 256, 1024, 256, (bf16*)(WS + WS_WDQ + (size_t)l * 512 * KiB), IN(I_MIXN) + (2 + l) * 1024, false, cscr, gw, NGW, lane, base);
            conv_job(IN(I_BWUQ) + (size_t)l * 256 * 1536, 256, 1536, (bf16*)(WS + WS_WUQ + (size_t)l * 768 * KiB), IN(I_BQN) + l * 256, false, cscr, gw, NGW, lane, base);
            conv_job(IN(I_BWO) + (size_t)l * 1024 * 1024, 1024, 1024, (bf16*)(WS + WS_WO + (size_t)l * 2 * MiB), nullptr, false, cscr, gw, NGW, lane, base);
        }
        conv_job(IN(I_WDKV), 1024, 160, (bf16*)(WS + WS_WDKV), IN(I_KVN), false, cscr, gw, NGW, lane, base);
        conv_job(IN(I_WUK), 128, 1024, (bf16*)(WS + WS_WUK), nullptr, false, cscr, gw, NGW, lane, base);
        conv_job(IN(I_WUV), 128, 1024, (bf16*)(WS + WS_WUV), nullptr, false, cscr, gw, NGW, lane, base);
    }

    for (int l = 0; l < 4; ++l) {
        if (G != 256 || l == 0) { ARGP(); TIDLANE(); int base = 0;
            conv_job(IN(I_F1GU) + (size_t)l * 1024 * 5632, 1024, 5632, (bf16*)(WS + WS_WGU1), IN(I_F1N) + l * 1024, true, cscr, gw, NGW, lane, base);
            conv_job(IN(I_F1D) + (size_t)l * 2816 * 1024, 2816, 1024, (bf16*)(WS + WS_WD1), nullptr, false, cscr, gw, NGW, lane, base);
            if (G != 256) {
            conv_job(IN(I_F2GU) + (size_t)l * 1024 * 5632, 1024, 5632, (bf16*)(WS + WS_WGU2), IN(I_F2N) + l * 1024, true, cscr, gw, NGW, lane, base);
            conv_job(IN(I_F2D) + (size_t)l * 2816 * 1024, 2816, 1024, (bf16*)(WS + WS_WD2), nullptr, false, cscr, gw, NGW, lane, base); }
            __syncthreads(); }
        if (l == 0) grid.sync(); else if (G != 256) SEAM();
#if REP_CONV > 1
        if (RUN) { ARGP(); TIDLANE(); int base = 0;
            conv_job(IN(I_F1GU) + (size_t)l * 1024 * 5632, 1024, 5632, (bf16*)(WS + WS_WGU1), IN(I_F1N) + l * 1024, true, cscr, gw, NGW, lane, base);
            conv_job(IN(I_F1D) + (size_t)l * 2816 * 1024, 2816, 1024, (bf16*)(WS + WS_WD1), nullptr, false, cscr, gw, NGW, lane, base);
            conv_job(IN(I_F2GU) + (size_t)l * 1024 * 5632, 1024, 5632, (bf16*)(WS + WS_WGU2), IN(I_F2N) + l * 1024, true, cscr, gw, NGW, lane, base);
            conv_job(IN(I_F2D) + (size_t)l * 2816 * 1024, 2816, 1024, (bf16*)(WS + WS_WD2), nullptr, false, cscr, gw, NGW, lane, base);
            __syncthreads(); }
        SEAM();
#endif
        for (int step = 0; step < 3; ++step) { const int hv = 3 * l + step;
            size_t rA, rB; int rK; float ralpha;
            if (step != 1) {
                if (G == 256) {
                    for (int pass = 0; pass < 2; ++pass) {
                        if (pass == 1 && bx < 44) { ARGP();
                            subset_sync((unsigned*)(WS + WS_SUB) + 64 * (2 * l + (step >> 1)), 44u, bx < 8);
                            pg8::Gemm g{HID, (const bf16*)(WS + (step == 0 ? WS_WD1 : WS_WD2)), MT, DM, DFF}; pg8::FfnOrder S; S.so.init(MP, DM, G, bx); S.mode = 1;
                            pg8::EpiRes E{hv == 0 ? IN(I_XS) - (size_t)MP * DM : (const float*)HRES, HRES, hb, SH(hv + 1), 0.5f};
                            pg8::gemm_phase<pg8::EpiRes, pg8::FfnOrder, false, true>(lds, g, S, E); }
                        { ARGP(); pg8::Gemm g{hb, (const bf16*)(WS + (step == 0 ? WS_WGU1 : WS_WGU2)), MT, 2 * DFF, DM}; pg8::FfnOrder S; S.so.init(MP, 2 * DFF, G, bx); S.mode = pass ? 2 : 0;
                            pg8::EpiGU E{HID, SH(hv)};
                            pg8::gemm_phase<pg8::EpiGU, pg8::FfnOrder, true, true>(lds, g, S, E); }
                    }
                    if (bx >= 84 && (step == 0 || l < 3)) { ARGP(); TIDLANE(); int base = 0; const int cgw = (bx - 84) * NWAVES + wave, cng = (256 - 84) * NWAVES; const int cl = step == 0 ? l : l + 1;
                        conv_job(IN(step == 0 ? I_F2GU : I_F1GU) + (size_t)cl * 1024 * 5632, 1024, 5632, (bf16*)(WS + (step == 0 ? WS_WGU2 : WS_WGU1)), IN(step == 0 ? I_F2N : I_F1N) + cl * 1024, true, cscr, cgw, cng, lane, base);
                        conv_job(IN(step == 0 ? I_F2D : I_F1D) + (size_t)cl * 2816 * 1024, 2816, 1024, (bf16*)(WS + (step == 0 ? WS_WD2 : WS_WD1)), nullptr, false, cscr, cgw, cng, lane, base);
                        __syncthreads(); }
                } else {
                    ARGP(); pg8::Gemm g{hb, (const bf16*)(WS + (step == 0 ? WS_WGU1 : WS_WGU2)), MT, 2 * DFF, DM}; pg8::StaticOrder S; S.init(MT, 2 * DFF, G, bx);
                    pg8::EpiGU E{HID, SH(hv)};
                    pg8::gemm_phase<pg8::EpiGU, pg8::StaticOrder, true, true>(lds, g, S, E); }
                SEAM();
#if REP_GU > 1
                if (RUN) { ARGP(); pg8::Gemm g{hb, (const bf16*)(WS + (step == 0 ? WS_WGU1 : WS_WGU2)), MT, 2 * DFF, DM}; pg8::StaticOrder S; S.init(MT, 2 * DFF, G, bx);
                    pg8::EpiGU E{HID, SH(hv)};
                    pg8::gemm_phase<pg8::EpiGU, pg8::StaticOrder, true, true>(lds, g, S, E); }
                SEAM();
#endif
                rA = WS_SCR; rB = step == 0 ? WS_WD1 : WS_WD2; rK = DFF; ralpha = 0.5f;
            } else if (l < 2) {
                if (RUN) { ARGP(); pg8::Gemm g{hb, (const bf16*)(WS + WS_WIN + (size_t)l * 4 * MiB), MT, 2048, DM}; pg8::StaticOrder S; S.init(MT, 2048, G, bx);
                    pg8::EpiWin E{Zb, SH(hv), SV(l)};
                    pg8::gemm_phase<pg8::EpiWin, pg8::StaticOrder, true, true>(lds, g, S, E); }
                SEAM();
#ifndef NO_SG
                for (int rep = 0; rep < REP_OTH; ++rep) { if (rep) SEAM(); ARGP(); sg::phase(lds, Zb, Pb, SV(l), IN(I_AVN) + l * 1024, (const bf16*)(WS + WS_WM) + (size_t)l * 2 * 8 * 128 * 128, (const float*)(WS + WS_BSG) + l * 2 * 8 * 128,
                                   OUTP + OUT_AV + (size_t)l * MS * 1024, vcu, G); }
#endif
                SEAM();
                rA = WS_KN; rB = WS_WOUT + (size_t)l * 2 * MiB; rK = DM; ralpha = 1.f;
            } else {
                const int j = l - 2;
                if (RUN) { ARGP(); pg8::Gemm g{hb, (const bf16*)(WS + WS_WDQ + (size_t)j * 512 * KiB), MT, 256, DM}; pg8::StaticOrder S; S.init(MT, 256, G, bx);
                    pg8::EpiQL E{QLb, SH(hv), SQ(j)};
                    pg8::gemm_phase<pg8::EpiQL, pg8::StaticOrder, true, true>(lds, g, S, E); }
                SEAM();
                for (int rep = 0; rep < REP_OTH; ++rep) { if (rep) SEAM(); ARGP(); int kq = 256; asm volatile("" : "+s"(kq));
                    pg8::Gemm g{QLb, (const bf16*)(WS + WS_WUQ + (size_t)j * 768 * KiB), MT, 1536, kq}; pg8::StaticOrder S; S.init(MT, 1536, G, bx);
                    pg8::EpiQ E{Qb, SQ(j), rope, QSCALE};
                    pg8::gemm_phase<pg8::EpiQ, pg8::StaticOrder, true, true>(lds, g, S, E); }
                SEAM();
#ifndef NO_ATT
                if (RUN) { ARGP(); att::phase(lds, Qb, KNb, KRb, VTb, Ob, vcu, G); }
#if REP_ATT > 1
                SEAM();
                if (RUN) { ARGP(); att::phase(lds, Qb, KNb, KRb, VTb, Ob, vcu, G); }
#endif
#endif
                SEAM();
                rA = WS_SCR + SCR_O; rB = WS_WO + (size_t)j * 2 * MiB; rK = DM; ralpha = 1.f;
            }
            if (RUN) { ARGP(); pg8::Gemm g{(const bf16*)(WS + rA), (const bf16*)(WS + rB), MT, DM, rK}; pg8::StaticOrder S; S.init((step != 1 && G == 256) ? MP : MT, DM, G, bx);
                pg8::EpiRes E{(hv == 0 && G == 256) ? IN(I_XP) : (const float*)HRES, HRES, hb, SH(hv + 1), ralpha};
                pg8::gemm_phase<pg8::EpiRes, pg8::StaticOrder, true, true>(lds, g, S, E); }
            SEAM();
#if REP_RES > 1
            if (RUN) { ARGP(); pg8::Gemm g{(const bf16*)(WS + rA), (const bf16*)(WS + rB), MT, DM, rK}; pg8::StaticOrder S; S.init(MT, DM, G, bx);
                pg8::EpiRes E{HRES, HRES, hb, nullptr, 0.f};
                pg8::gemm_phase<pg8::EpiRes, pg8::StaticOrder, true, true>(lds, g, S, E); }
            SEAM();
#endif
        }
        if (l == 1) { const int hv = 6;
            if (RUN) { ARGP(); pg8::Gemm g{hb, (const bf16*)(WS + WS_WDKV), MT, 256, DM}; pg8::StaticOrder S; S.init(MT, 256, G, bx);
                pg8::EpiLat E{KVRAW, SH(hv), SC()};
                pg8::gemm_phase<pg8::EpiLat, pg8::StaticOrder, true, true>(lds, g, S, E); }
            SEAM();
            for (int rep = 0; rep < REP_OTH; ++rep) { if (rep) SEAM(); ARGP(); TIDLANE();
                for (int m = gw; m < MT; m += NGW) {
                    const bool smp = m >= MP; const int ms = m - MP; const int pos = smp ? PAST + (ms & 63) : (m & (SEQ - 1));
                    const size_t kvrow = smp ? (size_t)MP + (size_t)(ms >> 6) * KVS + PAST + (ms & 63) : (size_t)m;
                    const float* kv = KVRAW + (size_t)m * 160; const float r = __builtin_amdgcn_rsqf(pg8::ld_stat(SC() + m) * (1.f / 128.f) + EPS);
                    const float c0 = kv[2 * lane] * r * IN(I_CKVN)[2 * lane], c1 = kv[2 * lane + 1] * r * IN(I_CKVN)[2 * lane + 1];
                    float* co = smp ? OUTP + OUT_CKVS + (size_t)ms * 128 : OUTP + OUT_CKVP + (size_t)m * 128;
                    co[2 * lane] = c0; co[2 * lane + 1] = c1;
                    ((unsigned*)(CKVALL + kvrow * 128))[lane] = cvtpk(c0, c1);
                    if (lane < 16) { const float x1 = kv[128 + lane], x2 = kv[144 + lane], c = rope[pos * 32 + lane], s = rope[pos * 32 + 16 + lane];
                        const float o1 = x1 * c - x2 * s, o2 = x2 * c + x1 * s;
                        float* ko = smp ? OUTP + OUT_KRS + (size_t)ms * 32 : OUTP + OUT_KRP + (size_t)m * 32;
                        ko[lane] = o1; ko[16 + lane] = o2;
                        const unsigned w = cvtpk(o1, o2); KRb[kvrow * 32 + lane] = (bf16)(w & 0xffffu); KRb[kvrow * 32 + 16 + lane] = (bf16)(w >> 16); }
                }
                for (int m = gw; m < 8 * PAST; m += NGW) { const int b = m / PAST, t = m % PAST; const size_t kvrow = (size_t)MP + (size_t)b * KVS + t;
                    const float* cc = IN(I_CCKV) + (size_t)m * 128; ((unsigned*)(CKVALL + kvrow * 128))[lane] = cvtpk(cc[2 * lane], cc[2 * lane + 1]);
                    if (lane < 16) { const float* ck = IN(I_CKR) + (size_t)m * 32; ((unsigned*)(KRb + kvrow * 32))[lane] = cvtpk(ck[2 * lane], ck[2 * lane + 1]); } }
            }
            SEAM();
            for (int rep = 0; rep < REP_OTH; ++rep) { if (rep) SEAM(); ARGP();
                { int kq = 128; asm volatile("" : "+s"(kq)); pg8::Gemm g{CKVALL, (const bf16*)(WS + WS_WUK), NKV, 1024, kq}; pg8::StaticOrder S; S.init(NKV, 1024, G, bx);
                  pg8::EpiPlain<1024> E{KNb};
                  pg8::gemm_phase<pg8::EpiPlain<1024>, pg8::StaticOrder, false, true>(lds, g, S, E); }
            }
            { ARGP();
                { int kq = 128; asm volatile("" : "+s"(kq)); pg8::Gemm g{(const bf16*)(WS + WS_WUV), CKVALL, 1024, NKV, kq}; pg8::StaticOrder S; S.init(1024, NKV, G, bx);
                  pg8::EpiPlain<NKV> E{VTb};
                  pg8::gemm_phase<pg8::EpiPlain<NKV>, pg8::StaticOrder, false, true>(lds, g, S, E); }
            }
            SEAM();
        }
    }
    if (RUN) { ARGP(); TIDLANE();
        for (int m = gw; m < MT; m += NGW) { const float r = __builtin_amdgcn_rsqf(pg8::ld_stat(SH(12) + m) * (1.f / 1024.f) + EPS);
#pragma unroll
            for (int j = 0; j < 4; ++j) { float* p = HRES + (size_t)m * DM + 256 * j + 4 * lane; const f32x4 v = *(const f32x4*)p, gn = *(const f32x4*)(IN(I_FN) + 256 * j + 4 * lane); *(f32x4*)p = v * r * gn; } }
    }
}

#undef G
#undef bx
#undef vcu
#undef gw
#undef NGW
#undef wave
#undef cscr
#undef stats
#undef scr
#undef rope
#undef hb
#undef IN
extern "C" void kernel_launch(void* const* d_in, const int* in_sizes, int n_in, void* d_out, int out_size, void* d_ws, size_t ws_size, hipStream_t stream) {
    static int grid = 0;
    if (grid == 0) {
        if (n_in != 26 || (size_t)out_size != OUT_END || ws_size < WS_END) { fprintf(stderr, "kernel_launch: unexpected shapes (n_in %d out %d ws %zu)\n", n_in, out_size, ws_size); grid = -1; return; }
        int dev = 0, cus = 0, per_cu = 0;
        hipGetDevice(&dev); hipDeviceGetAttribute(&cus, hipDeviceAttributeMultiprocessorCount, dev);
        if (hipFuncSetAttribute((const void*)mk_fwd, hipFuncAttributeMaxDynamicSharedMemorySize, LDS_BYTES) != hipSuccess) { fprintf(stderr, "kernel_launch: hipFuncSetAttribute failed\n"); grid = -1; return; }
        if (hipOccupancyMaxActiveBlocksPerMultiprocessor(&per_cu, (const void*)mk_fwd, NWAVES * 64, LDS_BYTES) != hipSuccess || per_cu < 1) { fprintf(stderr, "kernel_launch: occupancy query failed (%d)\n", per_cu); per_cu = 1; }
        (void)hipGetLastError();
        grid = cus * per_cu;
        fprintf(stderr, "kernel_launch: grid %d (%d CUs x %d)\n", grid, cus, per_cu);
    }
    if (grid < 0) return;
    if (hipMemsetAsync((char*)d_ws + WS_BAR, 0, 16 * KiB + 16 * 256, stream) != hipSuccess) { fprintf(stderr, "kernel_launch: memset failed\n"); return; }
    Args a{};
    for (int i = 0; i < 26; ++i) a.in[i] = (const float*)d_in[i];
    a.out = (float*)d_out; a.ws = (unsigned char*)d_ws; a.ph_lo = 0; a.ph_hi = 1 << 20;
    void* params[] = {&a};
    hipError_t e = hipLaunchCooperativeKernel((const void*)mk_fwd, dim3(grid), dim3(NWAVES * 64), params, LDS_BYTES, stream);
    if (e != hipSuccess) fprintf(stderr, "kernel_launch: cooperative launch failed: %s (grid %d)\n", hipGetErrorString(e), grid);
}
```

```cpp
#include <hip/hip_runtime.h>
#include <hip/hip_cooperative_groups.h>
#include <cstdio>
#include <cstdint>
namespace cg = cooperative_groups;
__device__ __forceinline__ int opaque_tid() { int t = threadIdx.x; asm volatile("" : "+v"(t)); return t; }
namespace pg8 {
#define PG8_LAS __attribute__((address_space(3)))
typedef unsigned short bf16_t;
typedef short bf16x8 __attribute__((ext_vector_type(8)));
typedef float f32x4 __attribute__((ext_vector_type(4)));
typedef unsigned u32x4 __attribute__((ext_vector_type(4)));
constexpr int BM = 256, BK = 64, HALF = 128, HTB = HALF * BK * 2  , STAGE_BYTES = 8 * HTB, NXCD = 8, WGM = 8;

__host__ __device__ __forceinline__ int lds_byte(int r, int c) { const int st = (r >> 4) * 2 + (c >> 5), rr = r & 15, cc = c & 31, ob = rr * 64 + cc * 2; return st * 1024 + (ob ^ (((ob >> 9) & 1) << 5)); }
__host__ __device__ __forceinline__ void stage_rc(int b, int& R, int& C) { const int st = b / 1024, sb = b % 1024, swz = sb ^ (((sb >> 9) & 1) << 5); R = (st >> 1) * 16 + swz / 64; C = (st & 1) * 32 + (swz % 64) / 2; }
__host__ __device__ __forceinline__ int perm32(int rho) { const int n = rho >> 4, i = rho & 15; return 8 * (i >> 2) + 4 * n + (i & 3); }

struct Unit { int pm, pn; };
struct Gemm { const bf16_t* A; const bf16_t* Bt; int M, N, K; };

struct StaticOrder {
    int nM, nN, nwg, G, c;
    __host__ __device__ void init(int M, int N, int G_, int c_) { nM = M / BM; nN = N / BM; nwg = nM * nN; G = G_; c = c_; }
    __host__ __device__ bool next(int i, Unit& u) const { return at(i * G + c, u); }
    __host__ __device__ bool at(int L, Unit& u) const {
        if (L >= nwg) return false;
        int wgid = (int)L; { const int q = nwg / NXCD, r = nwg % NXCD, xcd = wgid % NXCD, off = wgid / NXCD; wgid = (xcd < r ? xcd * (q + 1) : r * (q + 1) + (xcd - r) * q) + off; }
        const int nig = WGM * nN, gid = wgid / nig, fm = gid * WGM, gsz = (nM - fm) < WGM ? (nM - fm) : WGM;
        u.pm = fm + ((wgid % nig) % gsz); u.pn = (wgid % nig) / gsz; return true;
    }
    __device__ __forceinline__ void a_ready(const Unit&) const {}
    __device__ __forceinline__ void done(const Unit&) const {}
};

struct FfnOrder {
    StaticOrder so; int mode;
    __device__ __forceinline__ bool next(int i, Unit& u) const {
        const int c = so.c;
        if (mode == 0) { if (i > 0 || c >= 44) return false; u.pm = 128 + c / 22; u.pn = c % 22; return true; }
        if (mode == 1) { if (i > 0 || c >= 8) return false; u.pm = 128 + (c >> 2); u.pn = c & 3; return true; }
        int L;
        if (c < 8) { if (i >= 6) return false; L = i * so.G + c; }
        else if (i < 11) L = i * so.G + c;
        else if (i == 11 && c >= 44 && c < 84) { const int k = c - 44; L = (6 + (k >> 3)) * so.G + (k & 7); }
        else return false;
        return so.at(L, u);
    }
    __device__ __forceinline__ void a_ready(const Unit&) const {}
    __device__ __forceinline__ void done(const Unit&) const {}
};

typedef float f32x2 __attribute__((ext_vector_type(2)));
__device__ __forceinline__ f32x2 gelu_pk(f32x2 v) {
    const f32x2 av = __builtin_elementwise_abs(v), d = av * 0.2316418882f + 1.0f;
    f32x2 t; t.x = __builtin_amdgcn_rcpf(d.x); t.y = __builtin_amdgcn_rcpf(d.y);
    f32x2 q = t * 0.5307027145f + (-0.7265760135f); q = q * t + 0.7107068705f; q = q * t + (-0.142248368f); q = q * t + 0.127414796f; q = q * t;
    const f32x2 s = (v * v) * (-0.72134752044f);
    f32x2 e; e.x = __builtin_amdgcn_exp2f(s.x); e.y = __builtin_amdgcn_exp2f(s.y);
    const f32x2 m = v * (q * e), r = v - m;
    f32x2 o; o.x = v.x < 0.f ? m.x : r.x; o.y = v.y < 0.f ? m.y : r.y; return o;
}
typedef float f32x2_t __attribute__((ext_vector_type(2))); typedef __bf16 bf16x2_t __attribute__((ext_vector_type(2)));
typedef unsigned u32x2 __attribute__((ext_vector_type(2)));
__device__ __forceinline__ unsigned cvtpk(float lo, float hi) { f32x2_t v = {lo, hi}; bf16x2_t b = __builtin_convertvector(v, bf16x2_t); return __builtin_bit_cast(unsigned, b); }
__device__ __forceinline__ float ld_stat(const float* p) { return __hip_atomic_load(p, __ATOMIC_RELAXED, __HIP_MEMORY_SCOPE_AGENT); }
__device__ __forceinline__ void add_stat(float* p, float v) { (void)__hip_atomic_fetch_add(p, v, __ATOMIC_RELAXED, __HIP_MEMORY_SCOPE_AGENT); }
__device__ __forceinline__ float rstd_of(const float* ss, int row, float invd) { return __builtin_amdgcn_rsqf(ld_stat(ss + row) * invd + 1e-6f); }
__device__ __forceinline__ float red_fq(float s) { s += __shfl_xor(s, 16); s += __shfl_xor(s, 32); return s; }

struct EpiGU { static constexpr bool PERM = true, AFTER_DRAIN = false;
    bf16_t* H; const float* ss;
    __device__ __forceinline__ void operator()(const f32x4 (&acc)[2][2][4][2], const Unit& u, int wr, int wc, int fr, int fq) const {
        const int row0 = u.pm * BM + wr * 64 + fr, col0 = u.pn * 128 + wc * 32 + 8 * fq;
#pragma unroll
        for (int ai = 0; ai < 2; ++ai)
#pragma unroll
            for (int m = 0; m < 4; ++m) { const int row = row0 + ai * HALF + m * 16; const float r = rstd_of(ss, row, 1.f / 1024.f);
                float o[8];
#pragma unroll
                for (int n = 0; n < 2; ++n)
#pragma unroll
                    for (int j = 0; j < 4; ++j) { const float g = acc[ai][0][m][n][j] * r, uu = acc[ai][1][m][n][j] * r;
                        o[n * 4 + j] = g * uu * __builtin_amdgcn_rcpf(1.f + __builtin_amdgcn_exp2f(-1.4426950408889634f * g)); }
                u32x4 w; w.x = cvtpk(o[0], o[1]); w.y = cvtpk(o[2], o[3]); w.z = cvtpk(o[4], o[5]); w.w = cvtpk(o[6], o[7]);
                *(u32x4*)(H + (size_t)row * 2816 + col0) = w; }
    }
};
struct EpiRes { static constexpr bool PERM = true, AFTER_DRAIN = false;
    const float* base; float* h; bf16_t* hb; float* ssn; float alpha;
    __device__ __forceinline__ void operator()(const f32x4 (&acc)[2][2][4][2], const Unit& u, int wr, int wc, int fr, int fq) const {
        const int row0 = u.pm * BM + wr * 64 + fr, col0 = u.pn * BM + wc * 32 + 8 * fq;
#pragma unroll
        for (int ai = 0; ai < 2; ++ai)
#pragma unroll
            for (int m = 0; m < 4; ++m) { const int row = row0 + ai * HALF + m * 16; float s = 0.f;
#pragma unroll
                for (int bj = 0; bj < 2; ++bj) { const size_t off = (size_t)row * 1024 + col0 + bj * HALF;
                    f32x4 v0 = *(const f32x4*)(base + off), v1 = *(const f32x4*)(base + off + 4);
                    v0 = v0 + acc[ai][bj][m][0] * alpha; v1 = v1 + acc[ai][bj][m][1] * alpha;
                    *(f32x4*)(h + off) = v0; *(f32x4*)(h + off + 4) = v1;
                    u32x4 w; w.x = cvtpk(v0[0], v0[1]); w.y = cvtpk(v0[2], v0[3]); w.z = cvtpk(v1[0], v1[1]); w.w = cvtpk(v1[2], v1[3]); *(u32x4*)(hb + off) = w;
                    s += (v0[0] * v0[0] + v0[1] * v0[1]) + (v0[2] * v0[2] + v0[3] * v0[3]) + (v1[0] * v1[0] + v1[1] * v1[1]) + (v1[2] * v1[2] + v1[3] * v1[3]); }
                if (ssn) { s = red_fq(s); if (fq == 0) add_stat(ssn + row, s); }
                asm volatile("" ::: "memory"); }
    }
};
struct EpiWin { static constexpr bool PERM = true, AFTER_DRAIN = false;
    bf16_t* Z; const float* ss; float* ssv;
    __device__ __forceinline__ void operator()(const f32x4 (&acc)[2][2][4][2], const Unit& u, int wr, int wc, int fr, int fq) const {
        const int row0 = u.pm * BM + wr * 64 + fr, col0 = u.pn * BM + wc * 32 + 8 * fq;
#pragma unroll
        for (int ai = 0; ai < 2; ++ai)
#pragma unroll
            for (int m = 0; m < 4; ++m) { const int row = row0 + ai * HALF + m * 16; const float r = rstd_of(ss, row, 1.f / 1024.f); float s = 0.f;
#pragma unroll
                for (int bj = 0; bj < 2; ++bj) { const f32x4 v0 = acc[ai][bj][m][0] * r, v1 = acc[ai][bj][m][1] * r;
                    const f32x2 a = gelu_pk((f32x2){v0[0], v0[1]}), b = gelu_pk((f32x2){v0[2], v0[3]}), c = gelu_pk((f32x2){v1[0], v1[1]}), d = gelu_pk((f32x2){v1[2], v1[3]});
                    s += (a.x * a.x + a.y * a.y) + (b.x * b.x + b.y * b.y) + (c.x * c.x + c.y * c.y) + (d.x * d.x + d.y * d.y);
                    u32x4 w; w.x = cvtpk(a.x, a.y); w.y = cvtpk(b.x, b.y); w.z = cvtpk(c.x, c.y); w.w = cvtpk(d.x, d.y);
                    *(u32x4*)(Z + (size_t)row * 2048 + col0 + bj * HALF) = w; }
                if (u.pn >= 4) { s = red_fq(s); if (fq == 0) add_stat(ssv + row, s); } }
    }
};
struct EpiQL { static constexpr bool PERM = true, AFTER_DRAIN = false;
    bf16_t* QL; const float* ss; float* ssq;
    __device__ __forceinline__ void operator()(const f32x4 (&acc)[2][2][4][2], const Unit& u, int wr, int wc, int fr, int fq) const {
        const int row0 = u.pm * BM + wr * 64 + fr, col0 = wc * 32 + 8 * fq;
#pragma unroll
        for (int ai = 0; ai < 2; ++ai)
#pragma unroll
            for (int m = 0; m < 4; ++m) { const int row = row0 + ai * HALF + m * 16; const float r = rstd_of(ss, row, 1.f / 1024.f); float s = 0.f;
#pragma unroll
                for (int bj = 0; bj < 2; ++bj) { const f32x4 v0 = acc[ai][bj][m][0] * r, v1 = acc[ai][bj][m][1] * r;
                    s += (v0[0] * v0[0] + v0[1] * v0[1]) + (v0[2] * v0[2] + v0[3] * v0[3]) + (v1[0] * v1[0] + v1[1] * v1[1]) + (v1[2] * v1[2] + v1[3] * v1[3]);
                    u32x4 w; w.x = cvtpk(v0[0], v0[1]); w.y = cvtpk(v0[2], v0[3]); w.z = cvtpk(v1[0], v1[1]); w.w = cvtpk(v1[2], v1[3]);
                    *(u32x4*)(QL + (size_t)row * 256 + col0 + bj * HALF) = w; }
                s = red_fq(s); if (fq == 0) add_stat(ssq + row, s); }
    }
};
struct EpiQ { static constexpr bool PERM = false, AFTER_DRAIN = false;
    bf16_t* Q; const float* ssq; const float* rope; float qscale;
    __device__ __forceinline__ void operator()(const f32x4 (&acc)[2][2][4][2], const Unit& u, int wr, int wc, int fr, int fq) const {
        const int row0 = u.pm * BM + wr * 64 + fr, col0 = u.pn * BM + wc * 32 + 4 * fq;
#pragma unroll
        for (int ai = 0; ai < 2; ++ai)
#pragma unroll
            for (int m = 0; m < 4; ++m) { const int row = row0 + ai * HALF + m * 16; const float r = rstd_of(ssq, row, 1.f / 256.f) * qscale;
                const int pos = row < 32768 ? (row & 8191) : 2048 + ((row - 32768) & 63);
#pragma unroll
                for (int bj = 0; bj < 2; ++bj) { const int grp = u.pn * 8 + bj * 4 + wc;
                    f32x4 a = acc[ai][bj][m][0] * r, b = acc[ai][bj][m][1] * r;
                    if (grp % 3 == 2) { const f32x4 c = *(const f32x4*)(rope + pos * 32 + 4 * fq), s = *(const f32x4*)(rope + pos * 32 + 16 + 4 * fq);
                        const f32x4 a2 = a * c - b * s, b2 = b * c + a * s; a = a2; b = b2; }
                    bf16_t* qp = Q + (size_t)row * 1536 + col0 + bj * HALF;
                    u32x2 w; w.x = cvtpk(a[0], a[1]); w.y = cvtpk(a[2], a[3]); *(u32x2*)qp = w;
                    w.x = cvtpk(b[0], b[1]); w.y = cvtpk(b[2], b[3]); *(u32x2*)(qp + 16) = w; }
                asm volatile("" ::: "memory"); }
    }
};
struct EpiLat { static constexpr bool PERM = false, AFTER_DRAIN = false;
    float* KV; const float* ss; float* ssc;
    __device__ __forceinline__ void operator()(const f32x4 (&acc)[2][2][4][2], const Unit& u, int wr, int wc, int fr, int fq) const {
        const int row0 = u.pm * BM + wr * 64 + fr, col0 = wc * 32 + 4 * fq;
#pragma unroll
        for (int ai = 0; ai < 2; ++ai)
#pragma unroll
            for (int m = 0; m < 4; ++m) { const int row = row0 + ai * HALF + m * 16; const float r = rstd_of(ss, row, 1.f / 1024.f); float s = 0.f;
#pragma unroll
                for (int bj = 0; bj < 2; ++bj)
#pragma unroll
                    for (int n = 0; n < 2; ++n) { const int col = col0 + bj * HALF + n * 16;
                        if (col < 160) { const f32x4 v = acc[ai][bj][m][n] * r; *(f32x4*)(KV + (size_t)row * 160 + col) = v;
                            if (col < 128) s += (v[0] * v[0] + v[1] * v[1]) + (v[2] * v[2] + v[3] * v[3]); } }
                s = red_fq(s); if (fq == 0) add_stat(ssc + row, s); }
    }
};
template <int LDC> struct EpiPlain { static constexpr bool PERM = true, AFTER_DRAIN = false;
    bf16_t* O;
    __device__ __forceinline__ void operator()(const f32x4 (&acc)[2][2][4][2], const Unit& u, int wr, int wc, int fr, int fq) const {
        const int row0 = u.pm * BM + wr * 64 + fr, col0 = u.pn * BM + wc * 32 + 8 * fq;
#pragma unroll
        for (int ai = 0; ai < 2; ++ai)
#pragma unroll
            for (int m = 0; m < 4; ++m) { const int row = row0 + ai * HALF + m * 16;
#pragma unroll
                for (int bj = 0; bj < 2; ++bj) { const f32x4 v0 = acc[ai][bj][m][0], v1 = acc[ai][bj][m][1];
                    u32x4 w; w.x = cvtpk(v0[0], v0[1]); w.y = cvtpk(v0[2], v0[3]); w.z = cvtpk(v1[0], v1[1]); w.w = cvtpk(v1[2], v1[3]);
                    *(u32x4*)(O + (size_t)row * LDC + col0 + bj * HALF) = w; } }
    }
};
template <class Epi, class Sched, bool ALIGN_EPI = false, bool SP2 = false>
__device__ __forceinline__ void gemm_phase(PG8_LAS unsigned char* lds, const Gemm g, const Sched& S, const Epi& E) {
    const int tid = opaque_tid(), wid = __builtin_amdgcn_readfirstlane(tid >> 6), lane = tid & 63, wr = wid >> 2, wc = wid & 3, fr = lane & 15, fq = lane >> 4;
    const int K = g.K, nt = K / BK;
    unsigned voffA[2], voffB[2];
#pragma unroll
    for (int i = 0; i < 2; ++i) { int R, C; stage_rc(tid * 16 + i * 8192, R, C); const int Rb = Epi::PERM ? ((R & ~31) + perm32(R & 31)) : R;
        voffA[i] = (unsigned)(R * K + C) * 2u; voffB[i] = (unsigned)(Rb * K + C) * 2u; }
    const size_t kstep = (size_t)(BK * 2);
    const size_t hstep = (size_t)HALF * K * 2;
    const size_t tstep = 2 * hstep;
    const unsigned ldsw = (unsigned)wid * 1024u;
    const int aoff = lds_byte(wr * 64 + fr, fq * 8), boff = lds_byte(wc * 32 + fr, fq * 8);
#define PG8_SA(b, h) (((b) * 2 + (h)) * HTB)
#define PG8_SB(b, h) ((4 + (b) * 2 + (h)) * HTB)
#define PG8_STAGE(bufoff, gbase, voff) do { _Pragma("unroll") for (int _i = 0; _i < 2; ++_i) \
        __builtin_amdgcn_global_load_lds((const unsigned*)((const char*)(gbase) + (voff)[_i]), (PG8_LAS unsigned*)(lds + (bufoff) + ldsw + _i * 8192), 16, 0, 0); } while (0)
#define PG8_LDA(dst, b, h) do { _Pragma("unroll") for (int m = 0; m < 4; ++m) _Pragma("unroll") for (int k = 0; k < 2; ++k) dst[m][k] = *(const PG8_LAS bf16x8*)(lds + PG8_SA(b, h) + aoff + m * 2048 + k * 1024); } while (0)
#define PG8_LDB(dst, b, h) do { _Pragma("unroll") for (int n = 0; n < 2; ++n) _Pragma("unroll") for (int k = 0; k < 2; ++k) dst[n][k] = *(const PG8_LAS bf16x8*)(lds + PG8_SB(b, h) + boff + n * 2048 + k * 1024); } while (0)
#define PG8_MMA(ai, bj, At, Bt) do { __builtin_amdgcn_s_setprio(1); _Pragma("unroll") for (int m = 0; m < 4; ++m) _Pragma("unroll") for (int n = 0; n < 2; ++n) _Pragma("unroll") for (int k = 0; k < 2; ++k) \
        acc[ai][bj][m][n] = __builtin_amdgcn_mfma_f32_16x16x32_bf16(Bt[n][k], At[m][k], acc[ai][bj][m][n], 0, 0, 0); __builtin_amdgcn_s_setprio(0); } while (0)
#define PG8_WAIT_V(n) asm volatile("s_waitcnt vmcnt(" #n ")" ::: "memory")
#define PG8_WAIT_L(n) asm volatile("s_waitcnt lgkmcnt(" #n ")" ::: "memory")
#define PG8_BAR __builtin_amdgcn_s_barrier()
#define PG8_SCHED __builtin_amdgcn_sched_barrier(0)
    Unit cur, nxt; int ui = 0;
    if (!S.next(0, cur)) return;
    f32x4 acc[2][2][4][2];
#pragma unroll
    for (int a = 0; a < 2; ++a)
#pragma unroll
        for (int b = 0; b < 2; ++b)
#pragma unroll
            for (int m = 0; m < 4; ++m)
#pragma unroll
                for (int n = 0; n < 2; ++n) acc[a][b][m][n] = (f32x4){0.f, 0.f, 0.f, 0.f};
    bf16x8 At[4][2], B0[2][2], B1[2][2];
    const char* cA = (const char*)g.A + (size_t)cur.pm * tstep; const char* cB = (const char*)g.Bt + (size_t)cur.pn * tstep;
    S.a_ready(cur);
    if constexpr (SP2) {
        PG8_STAGE(PG8_SB(0, 0), cB, voffB); PG8_STAGE(PG8_SB(0, 1), cB + hstep, voffB); PG8_STAGE(PG8_SA(0, 0), cA, voffA); PG8_STAGE(PG8_SA(0, 1), cA + hstep, voffA);
        if (wr == 1) PG8_BAR;
        PG8_WAIT_V(2); PG8_BAR;
        PG8_STAGE(PG8_SB(1, 0), cB + kstep, voffB); PG8_STAGE(PG8_SA(1, 0), cA + kstep, voffA); PG8_STAGE(PG8_SB(1, 1), cB + hstep + kstep, voffB);
        PG8_WAIT_V(6); PG8_BAR;
    } else {
        PG8_STAGE(PG8_SB(0, 0), cB, voffB); PG8_STAGE(PG8_SA(0, 0), cA, voffA); PG8_STAGE(PG8_SB(0, 1), cB + hstep, voffB); PG8_STAGE(PG8_SA(0, 1), cA + hstep, voffA);
        if (wr == 1) PG8_BAR;
        PG8_WAIT_V(4); PG8_BAR;
        PG8_STAGE(PG8_SB(1, 0), cB + kstep, voffB); PG8_STAGE(PG8_SA(1, 0), cA + kstep, voffA); PG8_STAGE(PG8_SB(1, 1), cB + hstep + kstep, voffB);
        PG8_WAIT_V(6); PG8_BAR;
    }
    for (;;) {
        const bool has_next = S.next(ui + 1, nxt);
        const char* nA = has_next ? (const char*)g.A + (size_t)nxt.pm * tstep : cA; const char* nB = has_next ? (const char*)g.Bt + (size_t)nxt.pn * tstep : cB;
        for (int t = 0; t < nt; t += 2) {
            const bool last = (t == nt - 2);
            const char* a1 = cA + (size_t)(t + 1) * kstep;
            const char* a2 = last ? nA : cA + (size_t)(t + 2) * kstep; const char* b2 = last ? nB : cB + (size_t)(t + 2) * kstep;
            const char* a3 = a2 + kstep; const char* b3 = b2 + kstep;
            if (last && has_next) S.a_ready(nxt);
            if constexpr (SP2) {
            PG8_LDB(B0, 0, 0); PG8_LDB(B1, 0, 1); PG8_SCHED; PG8_LDA(At, 0, 0); PG8_STAGE(PG8_SA(1, 1), a1 + hstep, voffA);
            PG8_WAIT_V(8); PG8_WAIT_L(0); PG8_BAR; PG8_MMA(0, 0, At, B0); PG8_MMA(0, 1, At, B1); PG8_BAR; PG8_SCHED;
            PG8_LDA(At, 0, 1); PG8_STAGE(PG8_SB(0, 0), b2, voffB); PG8_STAGE(PG8_SB(0, 1), b2 + hstep, voffB); PG8_STAGE(PG8_SA(0, 0), a2, voffA);
            PG8_WAIT_V(8); PG8_WAIT_L(0); PG8_BAR; PG8_MMA(1, 0, At, B0); PG8_MMA(1, 1, At, B1); PG8_BAR; PG8_SCHED;
            PG8_LDB(B0, 1, 0); PG8_LDB(B1, 1, 1); PG8_SCHED; PG8_LDA(At, 1, 0); PG8_STAGE(PG8_SA(0, 1), a2 + hstep, voffA);
            PG8_WAIT_V(8); PG8_WAIT_L(0); PG8_BAR; PG8_MMA(0, 0, At, B0); PG8_MMA(0, 1, At, B1); PG8_BAR; PG8_SCHED;
            PG8_LDA(At, 1, 1); PG8_STAGE(PG8_SB(1, 0), b3, voffB); PG8_STAGE(PG8_SB(1, 1), b3 + hstep, voffB); PG8_STAGE(PG8_SA(1, 0), a3, voffA);
            PG8_WAIT_V(8); PG8_WAIT_L(0); PG8_BAR; PG8_MMA(1, 0, At, B0); PG8_MMA(1, 1, At, B1); PG8_BAR; PG8_SCHED;
            } else {
            PG8_LDB(B0, 0, 0); PG8_SCHED; PG8_LDA(At, 0, 0); PG8_STAGE(PG8_SA(1, 1), a1 + hstep, voffA);
            PG8_WAIT_L(8); PG8_BAR; PG8_WAIT_L(0); PG8_MMA(0, 0, At, B0); PG8_BAR; PG8_SCHED;
            PG8_LDB(B1, 0, 1); PG8_STAGE(PG8_SB(0, 0), b2, voffB);
            PG8_BAR; PG8_WAIT_L(0); PG8_MMA(0, 1, At, B1); PG8_BAR;
            PG8_LDA(At, 0, 1); PG8_STAGE(PG8_SA(0, 0), a2, voffA);
            PG8_BAR; PG8_WAIT_L(0); PG8_MMA(1, 0, At, B0); PG8_BAR; PG8_SCHED;
            PG8_STAGE(PG8_SB(0, 1), b2 + hstep, voffB);
            PG8_WAIT_V(6); PG8_BAR; PG8_MMA(1, 1, At, B1); PG8_BAR;
            PG8_LDB(B0, 1, 0); PG8_SCHED; PG8_LDA(At, 1, 0); PG8_STAGE(PG8_SA(0, 1), a2 + hstep, voffA);
            PG8_WAIT_L(8); PG8_BAR; PG8_WAIT_L(0); PG8_MMA(0, 0, At, B0); PG8_BAR; PG8_SCHED;
            PG8_LDB(B1, 1, 1); PG8_STAGE(PG8_SB(1, 0), b3, voffB);
            PG8_BAR; PG8_WAIT_L(0); PG8_MMA(0, 1, At, B1); PG8_BAR;
            PG8_LDA(At, 1, 1); PG8_STAGE(PG8_SA(1, 0), a3, voffA);
            PG8_BAR; PG8_WAIT_L(0); PG8_MMA(1, 0, At, B0); PG8_BAR; PG8_SCHED;
            PG8_STAGE(PG8_SB(1, 1), b3 + hstep, voffB);
            PG8_WAIT_V(6); PG8_BAR; PG8_MMA(1, 1, At, B1); PG8_BAR;
            }
        }
        if constexpr (ALIGN_EPI) { if (wr == 0) PG8_BAR; }
        if constexpr (!Epi::AFTER_DRAIN) { E(acc, cur, wr, wc, fr, fq); S.done(cur); }
        if (!has_next) break;
#pragma unroll
        for (int a = 0; a < 2; ++a)
#pragma unroll
            for (int b = 0; b < 2; ++b)
#pragma unroll
                for (int m = 0; m < 4; ++m)
#pragma unroll
                    for (int n = 0; n < 2; ++n) acc[a][b][m][n] = (f32x4){0.f, 0.f, 0.f, 0.f};
        cur = nxt; cA = nA; cB = nB; ++ui;
        if constexpr (ALIGN_EPI) { if (wr == 1) PG8_BAR; }
    }
    PG8_WAIT_V(0);
    if constexpr (!ALIGN_EPI) { if (wr == 0) PG8_BAR; }
    PG8_BAR;
    if constexpr (Epi::AFTER_DRAIN) { E.fused(acc, cur, wr, wc, fr, fq, lds, wid, lane); S.done(cur); }
#undef PG8_SA
#undef PG8_SB
#undef PG8_STAGE
#undef PG8_LDA
#undef PG8_LDB
#undef PG8_MMA
#undef PG8_WAIT_V
#undef PG8_WAIT_L
#undef PG8_BAR
#undef PG8_SCHED
}
}

constexpr int MP = 32768, MS = 512, MT = MP + MS, DM = 1024, DFF = 2816, NKV = 49664, SEQ = 8192, PAST = 2048, KVS = PAST + 64;
constexpr float EPS = 1e-6f;
constexpr float QSCALE = 0.10206207261596577f * 1.4426950408889634f;
#define GAS __attribute__((address_space(1)))
#define LAS __attribute__((address_space(3)))
typedef unsigned short bf16;
typedef float f32x4 __attribute__((ext_vector_type(4)));
typedef float f32x16 __attribute__((ext_vector_type(16)));
typedef short bf16x8 __attribute__((ext_vector_type(8)));
typedef short s16x4 __attribute__((ext_vector_type(4)));
typedef unsigned u32x4 __attribute__((ext_vector_type(4)));
typedef unsigned u32x2 __attribute__((ext_vector_type(2)));
using pg8::cvtpk;

constexpr size_t MiB = 1u << 20, KiB = 1u << 10;
constexpr size_t WS_STATS = 0;
constexpr size_t WS_BSG = 3 * MiB;
constexpr size_t WS_BAR = 3 * MiB + 512 * KiB;
constexpr size_t WS_SUB = WS_BAR + 16 * KiB;
constexpr size_t WS_ROPE = 4 * MiB;
constexpr size_t WS_WIN = 5 * MiB;
constexpr size_t WS_WOUT = 13 * MiB;
constexpr size_t WS_WM = 17 * MiB;
constexpr size_t WS_WDKV = 18 * MiB;
constexpr size_t WS_WUK = 18 * MiB + 512 * KiB;
constexpr size_t WS_WUV = 18 * MiB + 768 * KiB;
constexpr size_t WS_WDQ = 19 * MiB;
constexpr size_t WS_WUQ = 20 * MiB;
constexpr size_t WS_WO = 21 * MiB + 512 * KiB;
constexpr size_t WS_WGU1 = 26 * MiB, WS_WD1 = 37 * MiB, WS_WGU2 = 42 * MiB + 512 * KiB, WS_WD2 = 53 * MiB + 512 * KiB;
constexpr size_t WS_HB = 59 * MiB;
constexpr size_t WS_SCR = 124 * MiB;
constexpr size_t WS_KN = 303 * MiB;
constexpr size_t WS_VT = 400 * MiB;
constexpr size_t WS_KR = 497 * MiB;
constexpr size_t WS_END = 501 * MiB;
constexpr size_t SCR_CKVALL = 32 * MiB, SCR_O = (size_t)MT * 1536 * 2, SCR_QL = SCR_O + (size_t)MT * 1024 * 2;
static_assert(SCR_QL + (size_t)MT * 256 * 2 <= 179 * MiB, "scratch");
constexpr size_t OUT_Y = 0, OUT_CKVP = (size_t)MT * DM, OUT_KRP = OUT_CKVP + (size_t)MP * 128, OUT_CKVS = OUT_KRP + (size_t)MP * 32, OUT_KRS = OUT_CKVS + (size_t)MS * 128,
                 OUT_AV = OUT_KRS + (size_t)MS * 32, OUT_END = OUT_AV + (size_t)2 * MS * 1024;

constexpr int LDS_BYTES = 147456;
constexpr int NWAVES = 8;
#ifndef REP_ATT
#define REP_ATT 1
#endif
#ifndef REP_CONV
#define REP_CONV 1
#endif
#ifndef REP_OTH
#define REP_OTH 1
#endif
#ifndef REP_PRO
#define REP_PRO 1
#endif
#ifndef REP_RES
#define REP_RES 1
#endif
#ifndef REP_GU
#define REP_GU 1
#endif
#define LDS_WAIT() asm volatile("s_waitcnt lgkmcnt(0)" ::: "memory")
constexpr int XB_LDS_OFF = 147456 - 64;
constexpr int PTR_OFF = 131072;
__device__ __forceinline__ const void* ldptr(LAS unsigned char* lds, int i) { const volatile LAS unsigned* p = (const volatile LAS unsigned*)(lds + PTR_OFF) + 2 * i; const unsigned lo = __builtin_amdgcn_readfirstlane(p[0]), hi = __builtin_amdgcn_readfirstlane(p[1]); return (const void*)(((unsigned long long)hi << 32) | lo); }

struct Args { const float* in[26]; float* out; unsigned char* ws; int ph_lo, ph_hi; };
enum { I_XP = 0, I_XS, I_CCKV, I_CKR, I_F1N, I_F1GU, I_F1D, I_MIXN, I_F2N, I_F2GU, I_F2D, I_AWIN, I_AVN, I_AWS, I_ABS, I_AWOUT, I_KVN, I_WDKV, I_CKVN, I_WUK, I_WUV, I_BWDQ, I_BQN, I_BWUQ, I_BWO, I_FN };

__device__ __forceinline__ float wave_sum(float v) {
#pragma unroll
    for (int o = 1; o < 64; o <<= 1) v += __shfl_xor(v, o);
    return v;
}

__device__ __forceinline__ void tr_item(const float* W, int N, bf16* WT, int ldk, const float* gain, LAS float* scr, int k0, int n0, int drow0, int lane) {
#pragma unroll 8
    for (int i = 0; i < 32; ++i) { const int kk = 2 * i + (lane >> 5); float w = W[(size_t)(k0 + kk) * N + n0 + (lane & 31)]; if (gain) w *= gain[k0 + kk]; scr[kk * 33 + (lane & 31)] = w; }
    LDS_WAIT(); asm volatile("" ::: "memory");
    const int c = lane & 7;
#pragma unroll
    for (int j = 0; j < 4; ++j) { const int n = (lane >> 3) + 8 * j; const LAS float* s = scr + (8 * c) * 33 + n;
        u32x4 o; o.x = cvtpk(s[0 * 33], s[1 * 33]); o.y = cvtpk(s[2 * 33], s[3 * 33]); o.z = cvtpk(s[4 * 33], s[5 * 33]); o.w = cvtpk(s[6 * 33], s[7 * 33]);
        *(u32x4*)(WT + (size_t)(drow0 + n) * ldk + k0 + 8 * c) = o; }
    LDS_WAIT(); asm volatile("" ::: "memory");
}
__device__ __forceinline__ void tr_item64(const float* W, int N, bf16* WT, int ldk, const float* gain, LAS float* scr, int k0, int n0, int drow0, int lane) {
    const int rr = lane >> 4, c4 = lane & 15;
    f32x4 v[16];
#pragma unroll
    for (int i = 0; i < 16; ++i) v[i] = *(const f32x4*)(W + (size_t)(k0 + 4 * i + rr) * N + n0 + 4 * c4);
#pragma unroll
    for (int i = 0; i < 16; ++i) { const int row = 4 * i + rr; const float g = gain ? gain[k0 + row] : 1.f; LAS float* s = scr + row * 65 + 4 * c4;
        s[0] = v[i][0] * g; s[1] = v[i][1] * g; s[2] = v[i][2] * g; s[3] = v[i][3] * g; }
    LDS_WAIT(); asm volatile("" ::: "memory");
    const int nl = lane >> 3, kc = lane & 7;
#pragma unroll
    for (int j = 0; j < 8; ++j) { const int n = nl + 8 * j; const LAS float* s = scr + (8 * kc) * 65 + n;
        u32x4 o; o.x = cvtpk(s[0 * 65], s[1 * 65]); o.y = cvtpk(s[2 * 65], s[3 * 65]); o.z = cvtpk(s[4 * 65], s[5 * 65]); o.w = cvtpk(s[6 * 65], s[7 * 65]);
        *(u32x4*)(WT + (size_t)(drow0 + n) * ldk + k0 + 8 * kc) = o; }
    LDS_WAIT(); asm volatile("" ::: "memory");
}
__device__ __forceinline__ void conv_job(const float* W, int K, int N, bf16* WT, const float* gain, bool gu, LAS float* scr, int gw, int NGW, int lane, int& base) {
    const bool wide = (N & 63) == 0; const int bn = wide ? 64 : 32;
    const int nnb = N / bn, nitems = (K / 64) * nnb;
    int first = (gw - (base % NGW) + NGW) % NGW;
    for (int it = first; it < nitems; it += NGW) { const int kb = it / nnb, nb = it % nnb, n0 = bn * nb;
        int drow0 = n0;
        if (gu) { const int j = n0 < DFF ? n0 : n0 - DFF; drow0 = (j >> 7) * 256 + (j & 127) + (n0 < DFF ? 0 : 128); }
        if (wide) tr_item64(W, N, WT, K, gain, scr, 64 * kb, n0, drow0, lane); else tr_item(W, N, WT, K, gain, scr, 64 * kb, n0, drow0, lane); }
    base += nitems;
}

namespace att {
constexpr int KROW = 208, VROW = 136, KBUF = 64 * KROW, VBUF = 64 * VROW, K_OFF = 0, V_OFF = 2 * KBUF, WS_OFF = V_OFF + 2 * VBUF;
#define MFMA32(a, b, c) __builtin_amdgcn_mfma_f32_32x32x16_bf16((a), (b), (c), 0, 0, 0)
__device__ __forceinline__ void unit(LAS unsigned char* lds, const bf16* __restrict__ Q, const bf16* __restrict__ KN, const bf16* __restrict__ KR, const bf16* __restrict__ VT, bf16* __restrict__ O,
                                     int qrow0, int kvbase, int NT, int tmax, int h) {
    const int tid = opaque_tid(), lane = tid & 63, r32 = lane & 31, hi = lane >> 5; const int wid = __builtin_amdgcn_readfirstlane(tid >> 6);
    const bool active = tmax >= 0;
    const int r0 = tid / 12, c0 = tid % 12, e1 = 512 + tid, r1 = e1 / 12, c1 = e1 % 12; const bool has1 = tid < 256;
    const bf16* s0 = c0 < 8 ? KN + (size_t)(kvbase + r0) * 1024 + h * 64 + c0 * 8 : KR + (size_t)(kvbase + r0) * 32 + (c0 - 8) * 8; const size_t st0 = c0 < 8 ? 64 * 1024 : 64 * 32;
    const bf16* s1 = c1 < 8 ? KN + (size_t)(kvbase + r1) * 1024 + h * 64 + c1 * 8 : KR + (size_t)(kvbase + r1) * 32 + (c1 - 8) * 8; const size_t st1 = c1 < 8 ? 64 * 1024 : 64 * 32;
    const int vd = tid >> 3, vc = tid & 7;
    const bf16* sv = VT + (size_t)(h * 64 + vd) * NKV + kvbase + vc * 8;
    const int kd0 = K_OFF + r0 * KROW + c0 * 16, kd1 = K_OFF + r1 * KROW + c1 * 16, vdst = V_OFF + vd * VROW + vc * 16;
    bf16x8 qr[6];
    const int qrow = qrow0 + 32 * (active ? wid : 0) + r32;
#pragma unroll
    for (int d0 = 0; d0 < 6; ++d0) qr[d0] = *(const bf16x8*)(Q + (size_t)qrow * 1536 + h * 96 + d0 * 16 + hi * 8);
    float mref = 0.f, lrun = 0.f; f32x16 o0 = {}, o1 = {}, negm = {};
    u32x4 k0v = *(const u32x4*)s0, k1v = has1 ? *(const u32x4*)s1 : (u32x4){0u, 0u, 0u, 0u}, vv = *(const u32x4*)sv;
    u32x4 k0w = k0v, k1w = k1v, vw = vv;
    if (NT > 1) { k0w = *(const u32x4*)(s0 + st0); if (has1) k1w = *(const u32x4*)(s1 + st1); vw = *(const u32x4*)(sv + 64); }
    *(LAS u32x4*)(lds + kd0) = k0v; if (has1) *(LAS u32x4*)(lds + kd1) = k1v; *(LAS u32x4*)(lds + vdst) = vv;
    k0v = k0w; k1v = k1w; vv = vw;
    __syncthreads();
    LAS float* wsf = (LAS float*)(lds + WS_OFF) + wid * 32;
    for (int t = 0; t < NT; ++t) {
        const int cur = t & 1; const bool more = t + 1 < NT;
        if (t + 2 < NT) { k0w = *(const u32x4*)(s0 + (size_t)(t + 2) * st0); if (has1) k1w = *(const u32x4*)(s1 + (size_t)(t + 2) * st1); vw = *(const u32x4*)(sv + (size_t)(t + 2) * 64); }
        if (t <= tmax) {
            const LAS unsigned char* Kb = lds + K_OFF + cur * KBUF + r32 * KROW + hi * 16; const LAS unsigned char* Vb = lds + V_OFF + cur * VBUF + r32 * VROW + hi * 8;
            bf16x8 kf[12];
#pragma unroll
            for (int d0 = 0; d0 < 6; ++d0) { kf[2 * d0] = *(const LAS bf16x8*)(Kb + d0 * 32); kf[2 * d0 + 1] = *(const LAS bf16x8*)(Kb + 32 * KROW + d0 * 32); }
            __builtin_amdgcn_sched_barrier(0);
            f32x16 p0 = MFMA32(kf[0], qr[0], negm), p1 = MFMA32(kf[1], qr[0], negm);
#pragma unroll
            for (int d0 = 1; d0 < 6; ++d0) { p0 = MFMA32(kf[2 * d0], qr[d0], p0); p1 = MFMA32(kf[2 * d0 + 1], qr[d0], p1); }
            s16x4 vl0[4], vh0[4], vl1[4], vh1[4];
#pragma unroll
            for (int ks = 0; ks < 4; ++ks) { vl0[ks] = *(const LAS s16x4*)(Vb + ks * 32); vh0[ks] = *(const LAS s16x4*)(Vb + ks * 32 + 16);
                vl1[ks] = *(const LAS s16x4*)(Vb + 32 * VROW + ks * 32); vh1[ks] = *(const LAS s16x4*)(Vb + 32 * VROW + ks * 32 + 16); }
            __builtin_amdgcn_sched_barrier(0);
            float ma = __builtin_fmaxf(__builtin_fmaxf(p0[0], p0[1]), p1[0]), mb = __builtin_fmaxf(__builtin_fmaxf(p0[2], p0[3]), p1[1]);
            ma = __builtin_fmaxf(__builtin_fmaxf(ma, p1[2]), p1[3]);
#pragma unroll
            for (int i = 4; i < 16; i += 4) { ma = __builtin_fmaxf(__builtin_fmaxf(ma, p0[i]), p0[i + 1]); mb = __builtin_fmaxf(__builtin_fmaxf(mb, p0[i + 2]), p0[i + 3]);
                ma = __builtin_fmaxf(__builtin_fmaxf(ma, p1[i]), p1[i + 1]); mb = __builtin_fmaxf(__builtin_fmaxf(mb, p1[i + 2]), p1[i + 3]); }
            float mx = __builtin_fmaxf(ma, mb); mx = __builtin_fmaxf(mx, __shfl_xor(mx, 32));
            if (t == 0 || __any(mx > 8.0f)) {
                const float dl = t == 0 ? mx : __builtin_fmaxf(mx, 0.f); mref += dl;
#pragma unroll
                for (int i = 0; i < 16; ++i) { p0[i] -= dl; p1[i] -= dl; negm[i] = -mref; }
                if (t != 0) { const float fsc = __builtin_amdgcn_exp2f(-dl); lrun *= fsc;
                    if (hi == 0) wsf[r32] = fsc;
#pragma unroll
                    for (int g = 0; g < 4; ++g) { const f32x4 a = *(const LAS f32x4*)(wsf + 8 * g + 4 * hi);
#pragma unroll
                        for (int j = 0; j < 4; ++j) { o0[4 * g + j] *= a[j]; o1[4 * g + j] *= a[j]; } } }
            }
            typedef float f32x2v __attribute__((ext_vector_type(2)));
            f32x2v rs2 = {0.f, 0.f};
#pragma unroll
            for (int i = 0; i < 16; ++i) { p0[i] = __builtin_amdgcn_exp2f(p0[i]); p1[i] = __builtin_amdgcn_exp2f(p1[i]); }
#pragma unroll
            for (int i = 0; i < 16; i += 2) { rs2 += (f32x2v){p0[i], p0[i + 1]}; rs2 += (f32x2v){p1[i], p1[i + 1]}; }
            lrun += rs2.x + rs2.y;
            bf16x8 pa[4];
#pragma unroll
            for (int s = 0; s < 2; ++s) { u32x4 w0, w1;
                w0.x = cvtpk(p0[8 * s + 0], p0[8 * s + 1]); w0.y = cvtpk(p0[8 * s + 2], p0[8 * s + 3]); w0.z = cvtpk(p0[8 * s + 4], p0[8 * s + 5]); w0.w = cvtpk(p0[8 * s + 6], p0[8 * s + 7]);
                w1.x = cvtpk(p1[8 * s + 0], p1[8 * s + 1]); w1.y = cvtpk(p1[8 * s + 2], p1[8 * s + 3]); w1.z = cvtpk(p1[8 * s + 4], p1[8 * s + 5]); w1.w = cvtpk(p1[8 * s + 6], p1[8 * s + 7]);
                pa[s] = __builtin_bit_cast(bf16x8, w0); pa[2 + s] = __builtin_bit_cast(bf16x8, w1); }
#pragma unroll
            for (int ks = 0; ks < 4; ++ks) {
                const s16x4 l0 = vl0[ks], h0 = vh0[ks], l1 = vl1[ks], h1 = vh1[ks];
                const bf16x8 v0 = {l0[0], l0[1], l0[2], l0[3], h0[0], h0[1], h0[2], h0[3]}, v1 = {l1[0], l1[1], l1[2], l1[3], h1[0], h1[1], h1[2], h1[3]};
                o0 = MFMA32(pa[ks], v0, o0); o1 = MFMA32(pa[ks], v1, o1); }
        }
        if (more) { const int nb = cur ^ 1; *(LAS u32x4*)(lds + kd0 + nb * KBUF) = k0v; if (has1) *(LAS u32x4*)(lds + kd1 + nb * KBUF) = k1v; *(LAS u32x4*)(lds + vdst + nb * VBUF) = vv; }
        k0v = k0w; k1v = k1w; vv = vw;
        __syncthreads();
    }
    if (active) {
        lrun += __shfl_xor(lrun, 32);
        if (hi == 0) wsf[r32] = 1.f / lrun;
        bf16* Ow = O + (size_t)(qrow0 + 32 * wid) * 1024 + h * 64 + r32;
#pragma unroll
        for (int g = 0; g < 4; ++g) { const f32x4 inv = *(const LAS f32x4*)(wsf + 8 * g + 4 * hi);
#pragma unroll
            for (int j = 0; j < 4; ++j) { const int row = 8 * g + 4 * hi + j; const unsigned w = cvtpk(o0[4 * g + j] * inv[j], o1[4 * g + j] * inv[j]);
                Ow[(size_t)row * 1024] = (bf16)(w & 0xffffu); Ow[(size_t)row * 1024 + 32] = (bf16)(w >> 16); } }
    }
}
__device__ __forceinline__ void phase(LAS unsigned char* lds, const bf16* Q, const bf16* KN, const bf16* KR, const bf16* VT, bf16* O, int vcu, int G) {
    const int wid = __builtin_amdgcn_readfirstlane((int)threadIdx.x >> 6);
    for (int p = vcu; p < 1024 + 128; p += G) {
        const int nsub = p < 1024 ? 2 : 1;
        for (int sub = 0; sub < nsub; ++sub) {
            int qrow0, kvbase, NT, tmax, h;
            if (p < 1024) { const int bh = p >> 4, pp = p & 15, b = bh >> 4, qb = sub ? pp : 31 - pp; h = bh & 15; qrow0 = b * SEQ + qb * 256; kvbase = b * SEQ; NT = 4 * qb + 4; tmax = 4 * qb + (wid >> 1); }
            else { const int su = p - 1024, sb = su >> 4; h = su & 15; qrow0 = MP + sb * 64; kvbase = MP + sb * KVS; NT = KVS / 64; tmax = wid < 2 ? NT - 1 : -1; }
            unit(lds, Q, KN, KR, VT, O, qrow0, kvbase, NT, tmax, h);
        }
    }
}
}

namespace sg {
constexpr int VTROW = 272;
__device__ __forceinline__ void phase(LAS unsigned char* lds, const bf16* Z, bf16* P, const float* ssv, const float* vgain  , const bf16* Wm  , const float* bsg  ,
                                      float* av_out  , int vcu, int G) {
    const int tid = opaque_tid(), lane = tid & 63, fr = lane & 15, fq = lane >> 4; const int wid = __builtin_amdgcn_readfirstlane(tid >> 6);
    for (int un = vcu; un < (MT / 128) * 8; un += G) {
        const int blk = un >> 3, g = un & 7, r0 = blk * 128; const int typ = blk >= MP / 128 ? 1 : 0;
#pragma unroll
        for (int i = 0; i < 4; ++i) { const int e = tid + 512 * i, s = e >> 4, c8 = e & 15; const int row = r0 + s;
            const int ssw = s ^ (8 * c8);
            const u32x4 raw = *(const u32x4*)(Z + (size_t)row * 2048 + 1024 + g * 128 + c8 * 8);
            const float r = __builtin_amdgcn_rsqf(pg8::ld_stat(ssv + row) * (1.f / 1024.f) + EPS);
            const f32x4 g0 = *(const f32x4*)(vgain + g * 128 + c8 * 8), g1 = *(const f32x4*)(vgain + g * 128 + c8 * 8 + 4);
            float v[8];
#pragma unroll
            for (int j = 0; j < 4; ++j) { const unsigned w = raw[j]; v[2 * j] = __uint_as_float(w << 16); v[2 * j + 1] = __uint_as_float(w & 0xffff0000u); }
#pragma unroll
            for (int j = 0; j < 4; ++j) { v[j] *= r * g0[j]; v[4 + j] *= r * g1[j]; }
            if (typ) { float* ap = av_out + (size_t)(row - MP) * 1024 + g * 128 + c8 * 8; *(f32x4*)ap = (f32x4){v[0], v[1], v[2], v[3]}; *(f32x4*)(ap + 4) = (f32x4){v[4], v[5], v[6], v[7]}; }
#pragma unroll
            for (int j = 0; j < 4; ++j) { const unsigned w = cvtpk(v[2 * j], v[2 * j + 1]);
                *(LAS bf16*)(lds + (c8 * 8 + 2 * j) * VTROW + ssw * 2) = (bf16)(w & 0xffffu); *(LAS bf16*)(lds + (c8 * 8 + 2 * j + 1) * VTROW + ssw * 2) = (bf16)(w >> 16); }
        }
        __syncthreads();
        const bf16* W = Wm + ((size_t)(typ * 8 + g) * 128 + 16 * wid + fr) * 128 + 8 * fq;
        f32x4 acc[8];
#pragma unroll
        for (int n = 0; n < 8; ++n) acc[n] = (f32x4){0.f, 0.f, 0.f, 0.f};
#pragma unroll
        for (int k = 0; k < 4; ++k) {
            if (32 * k <= 16 * wid + 15) {
                const bf16x8 wf = *(const bf16x8*)(W + 32 * k);
#pragma unroll
                for (int n = 0; n < 8; ++n) { const bf16x8 vf = *(const LAS bf16x8*)(lds + (16 * n + fr) * VTROW + ((32 * k + 8 * fq) ^ (8 * (2 * n + (fr >> 3)))) * 2);
                    acc[n] = __builtin_amdgcn_mfma_f32_16x16x32_bf16(vf, wf, acc[n], 0, 0, 0); }
            }
        }
        const int t = 16 * wid + fr, row = r0 + t; const float bias = bsg[(typ * 8 + g) * 128 + t];
#pragma unroll
        for (int n = 0; n < 8; ++n) { const size_t col = (size_t)g * 128 + 16 * n + 4 * fq;
            const u32x2 ur = *(const u32x2*)(Z + (size_t)row * 2048 + col);
            const float u0 = __uint_as_float(ur.x << 16), u1 = __uint_as_float(ur.x & 0xffff0000u), u2 = __uint_as_float(ur.y << 16), u3 = __uint_as_float(ur.y & 0xffff0000u);
            u32x2 w; w.x = cvtpk(u0 * (acc[n][0] + bias), u1 * (acc[n][1] + bias)); w.y = cvtpk(u2 * (acc[n][2] + bias), u3 * (acc[n][3] + bias));
            *(u32x2*)(P + (size_t)row * 1024 + col) = w; }
        __syncthreads();
    }
}
}

typedef GAS unsigned gu32;
#define XB_TMO      128
#define XB_XCNT(j)  (256  + 64 * (j))
#define XB_XSUB(j)  (1280 + 64 * (j))
#define XB_XGEN(j)  (2304 + 64 * (j))
#define XB_TOP      3328
#define XB_TOPGEN   3392
#define XCD_BAR_WORDS 3456
#define XB_SPIN_CAP (1u << 18)

__device__ __forceinline__ unsigned xb_ld(unsigned* p)              { return __hip_atomic_load(p, __ATOMIC_RELAXED, __HIP_MEMORY_SCOPE_AGENT); }
__device__ __forceinline__ unsigned xb_add(unsigned* p, unsigned v) { return __hip_atomic_fetch_add(p, v, __ATOMIC_RELAXED, __HIP_MEMORY_SCOPE_AGENT); }
__device__ __forceinline__ unsigned xb_xcc_id() { return (unsigned)__builtin_amdgcn_s_getreg((3 << 11) | 20) & 0xFu; }
#define XB_SPIN(cond, bar) do { unsigned _sp = 0; while (cond) { __builtin_amdgcn_s_sleep(1); \
    if ((++_sp & 255u) == 0u) { if (xb_ld(&(bar)[XB_TMO])) break; if (_sp > XB_SPIN_CAP) { atomicAdd(&(bar)[XB_TMO], 1u); break; } } } } while (0)

struct XcdBarrier {
    unsigned* bar; unsigned x;
    volatile LAS unsigned* st;
};

__device__ __forceinline__ XcdBarrier xcd_barrier_post(unsigned* bar, volatile LAS unsigned* st) {
    XcdBarrier b; b.bar = bar; b.x = xb_xcc_id(); b.st = st;
    if (threadIdx.x == 0) (void)xb_add(&bar[XB_XCNT(b.x)], 1u);
    return b;
}
__device__ __forceinline__ void xcd_barrier_complete(unsigned* bar, unsigned x, unsigned& nloc, unsigned& nx) {
    const unsigned G = gridDim.x * gridDim.y * gridDim.z;
    unsigned sum, cnt, mine, sp = 0u;
    for (;;) {
        sum = 0u; cnt = 0u; mine = 0u;
#pragma unroll
        for (unsigned j = 0; j < 16; ++j) { const unsigned c = xb_ld(&bar[XB_XCNT(j)]); sum += c; cnt += (c > 0u) ? 1u : 0u; mine = (j == x) ? c : mine; }
        if (sum == G) break;
        __builtin_amdgcn_s_sleep(1);
        if ((++sp & 255u) == 0u) { if (xb_ld(&bar[XB_TMO])) break; if (sp > XB_SPIN_CAP) { atomicAdd(&bar[XB_TMO], 1u); break; } }
    }
    nloc = mine > 0u ? mine : 1u; nx = cnt > 0u ? cnt : 1u;
}

__device__ __forceinline__ void xcd_barrier(const XcdBarrier& b) {
    asm volatile("s_waitcnt vmcnt(0)" ::: "memory");
    __syncthreads();
    if (threadIdx.x == 0) {
        unsigned* bar = b.bar;
        __builtin_amdgcn_s_waitcnt(0);
        unsigned nloc = b.st[0], nx = b.st[1];
        if (nloc == 0u) { xcd_barrier_complete(bar, b.x, nloc, nx); b.st[0] = nloc; b.st[1] = nx; }
        const unsigned old = xb_add(&bar[XB_XSUB(b.x)], 1u);
        const unsigned gen = old / nloc;
        if (old + 1u == (gen + 1u) * nloc) {
            __builtin_amdgcn_fence(__ATOMIC_RELEASE, "agent");
            asm volatile("s_waitcnt vmcnt(0)" ::: "memory");
            const unsigned og = xb_add(&bar[XB_TOP], 1u);
            const unsigned tg = og / nx;
            if (og + 1u == (tg + 1u) * nx) xb_add(&bar[XB_TOPGEN], 1u);
            else XB_SPIN(xb_ld(&bar[XB_TOPGEN]) == tg, bar);
            __builtin_amdgcn_fence(__ATOMIC_ACQUIRE, "agent");
            xb_add(&bar[XB_XGEN(b.x)], 1u);
            asm volatile("s_waitcnt vmcnt(0)" ::: "memory");
        } else {
            XB_SPIN(xb_ld(&bar[XB_XGEN(b.x)]) == gen, bar);
            __builtin_amdgcn_fence(__ATOMIC_ACQUIRE, "agent");
            asm volatile("s_waitcnt vmcnt(0)" ::: "memory");
        }
    }
    __syncthreads();
}

__device__ __forceinline__ void subset_sync(unsigned* cnt, unsigned target, bool wait) {
    asm volatile("s_waitcnt vmcnt(0)" ::: "memory");
    __syncthreads();
    if (threadIdx.x == 0) {
        __builtin_amdgcn_fence(__ATOMIC_RELEASE, "agent");
        asm volatile("s_waitcnt vmcnt(0)" ::: "memory");
        (void)__hip_atomic_fetch_add(cnt, 1u, __ATOMIC_RELAXED, __HIP_MEMORY_SCOPE_AGENT);
        if (wait) { unsigned sp = 0;
            while (__hip_atomic_load(cnt, __ATOMIC_RELAXED, __HIP_MEMORY_SCOPE_AGENT) < target) { __builtin_amdgcn_s_sleep(2); if (++sp > (1u << 22)) break; }
            __builtin_amdgcn_fence(__ATOMIC_ACQUIRE, "agent");
            asm volatile("s_waitcnt vmcnt(0)" ::: "memory"); }
    }
    __syncthreads();
}
__global__ void __launch_bounds__(NWAVES * 64, 2) mk_fwd(Args args) {
    extern __shared__ __attribute__((aligned(16))) unsigned char lds_raw[];
    LAS unsigned char* lds = (LAS unsigned char*)lds_raw;
    cg::grid_group grid = cg::this_grid();
#define wave (__builtin_amdgcn_readfirstlane((int)threadIdx.x >> 6))
#define TIDLANE() const int tid = opaque_tid(), lane = tid & 63; (void)tid; (void)lane
#define G ((int)gridDim.x)
#define bx ((int)blockIdx.x)
#define vcu ((G % 8 == 0) ? (bx % 8) * (G / 8) + bx / 8 : bx)
#define gw (vcu * NWAVES + wave)
#define NGW (G * NWAVES)
#define ARGP() const __attribute__((address_space(4))) Args* ap = (const __attribute__((address_space(4))) Args*)__builtin_amdgcn_kernarg_segment_ptr(); asm volatile("" : "+s"(ap))
#define IN(i) (ap->in[(i)])
#define OUTP (ap->out)
#define WS (ap->ws)
#define stats ((float*)(WS + WS_STATS))
#define SH(k) (stats + (size_t)(k) * MT)
#define SV(l) (stats + (size_t)(13 + (l)) * MT)
#define SQ(j) (stats + (size_t)(15 + (j)) * MT)
#define SC() (stats + (size_t)17 * MT)
#define HRES (OUTP + OUT_Y)
#define hb ((bf16*)(WS + WS_HB))
#define scr (WS + WS_SCR)
#define HID ((bf16*)scr)
#define Zb ((bf16*)scr)
#define Pb ((bf16*)(WS + WS_KN))
#define KVRAW ((float*)scr)
#define CKVALL ((bf16*)(scr + SCR_CKVALL))
#define Qb ((bf16*)scr)
#define Ob ((bf16*)(scr + SCR_O))
#define QLb ((bf16*)(scr + SCR_QL))
#define KNb ((bf16*)(WS + WS_KN))
#define VTb ((bf16*)(WS + WS_VT))
#define KRb ((bf16*)(WS + WS_KR))
#define rope ((const float*)(WS + WS_ROPE))
#define cscr ((LAS float*)(lds + wave * 16640))
#define RUN true
    if (threadIdx.x < 2) ((volatile LAS unsigned*)(lds + XB_LDS_OFF))[threadIdx.x] = 0u;
    __syncthreads();
    XcdBarrier xbar = xcd_barrier_post((unsigned*)(args.ws + WS_BAR), (volatile LAS unsigned*)(lds + XB_LDS_OFF));
#define SEAM() xcd_barrier(xbar)

    for (int rep = 0; rep < REP_PRO; ++rep) { ARGP(); TIDLANE(); if (rep) grid.sync();
        for (size_t i = (size_t)MT + (size_t)bx * 512 + tid; i < (size_t)18 * MT; i += (size_t)G * 512) stats[i] = 0.f;
        for (int m = gw; m < MT; m += NGW) { const float* xr = m < MP ? IN(I_XP) + (size_t)m * DM : IN(I_XS) + (size_t)(m - MP) * DM;
            float s = 0.f;
#pragma unroll
            for (int j = 0; j < 4; ++j) { const f32x4 v = *(const f32x4*)(xr + 256 * j + 4 * lane); if (G != 256) *(f32x4*)(HRES + (size_t)m * DM + 256 * j + 4 * lane) = v;
                u32x2 w; w.x = cvtpk(v[0], v[1]); w.y = cvtpk(v[2], v[3]); *(u32x2*)(hb + (size_t)m * DM + 256 * j + 4 * lane) = w;
                s += (v[0] * v[0] + v[1] * v[1]) + (v[2] * v[2] + v[3] * v[3]); }
            s = wave_sum(s); if (lane == 0) SH(0)[m] = s; }
        for (int i = bx * 512 + tid; i < SEQ * 16; i += G * 512) { const int pos = i >> 4, k = i & 15; const float inv = 1.0f / powf(10000.0f, (float)k * (2.0f / 32.0f)); const float ang = (float)pos * inv;
            ((float*)(WS + WS_ROPE))[pos * 32 + k] = cosf(ang); ((float*)(WS + WS_ROPE))[pos * 32 + 16 + k] = sinf(ang); }
        for (int i = bx * 512 + tid; i < 2 * 2 * 8 * 128 * 128; i += G * 512) { const int s = i & 127, t = (i >> 7) & 127, g = (i >> 14) & 7, typ = (i >> 17) & 1, l = i >> 18;
            float w = 0.f;
            if (typ == 0) { if (s <= t) w = IN(I_AWS)[(((size_t)l * 8 + g) * 128 + t) * 128 + s]; }
            else { if ((s >> 6) == (t >> 6) && (s & 63) <= (t & 63)) w = IN(I_AWS)[(((size_t)l * 8 + g) * 128 + (t & 63)) * 128 + (s & 63)]; }
            ((bf16*)(WS + WS_WM))[i] = (bf16)(cvtpk(w, 0.f) & 0xffffu); }
        for (int i = bx * 512 + tid; i < 2 * 2 * 8 * 128; i += G * 512) { const int t = i & 127, g = (i >> 7) & 7, typ = (i >> 10) & 1, l = i >> 11;
            ((float*)(WS + WS_BSG))[i] = IN(I_ABS)[((size_t)l * 8 + g) * 128 + (typ ? (t & 63) : t)]; }
        for (int i = bx * 512 + tid; i < 96 * 1024 / 8; i += G * 512) ((u32x4*)(WS + WS_WDKV + (size_t)160 * 1024 * 2))[i] = (u32x4){0u, 0u, 0u, 0u};
        int base = 0;
        for (int l = 0; l < 2; ++l) {
            conv_job(IN(I_AWIN) + (size_t)l * 1024 * 2048, 1024, 2048, (bf16*)(WS + WS_WIN + (size_t)l * 4 * MiB), IN(I_MIXN) + l * 1024, false, cscr, gw, NGW, lane, base);
            conv_job(IN(I_AWOUT) + (size_t)l * 1024 * 1024, 1024, 1024, (bf16*)(WS + WS_WOUT + (size_t)l * 2 * MiB), nullptr, false, cscr, gw, NGW, lane, base);
            conv_job(IN(I_BWDQ) + (size_t)l * 1024 * 256, 1024, 256, (bf16*)(WS + WS_WDQ + (size_t)l * 512 * KiB), IN(I_MIXN) + (2 + l) * 1024, false, cscr, gw, NGW, lane, base);
            conv_job(IN(I_BWUQ) + (size_t)l * 256 * 1536, 256, 1536, (bf16*)(WS + WS_WUQ + (size_t)l * 768 * KiB), IN(I_BQN) + l * 256, false, cscr, gw, NGW, lane, base);
            conv_job(IN(I_BWO) + (size_t)l * 1024 * 1024, 1024, 1024, (bf16*)(WS + WS_WO + (size_t)l * 2 * MiB), nullptr, false, cscr, gw, NGW, lane, base);
        }
        conv_job(IN(I_WDKV), 1024, 160, (bf16*)(WS + WS_WDKV), IN(I_KVN), false, cscr, gw, NGW, lane, base);
        conv_job(IN(I_WUK), 128, 1024, (bf16*)(WS + WS_WUK), nullptr, false, cscr, gw, NGW, lane, base);
        conv_job(IN(I_WUV), 128, 1024, (bf16*)(WS + WS_WUV), nullptr, false, cscr, gw, NGW, lane, base);
    }

    for (int l = 0; l < 4; ++l) {
        if (G != 256 || l == 0) { ARGP(); TIDLANE(); int base = 0;
            conv_job(IN(I_F1GU) + (size_t)l * 1024 * 5632, 1024, 5632, (bf16*)(WS + WS_WGU1), IN(I_F1N) + l * 1024, true, cscr, gw, NGW, lane, base);
            conv_job(IN(I_F1D) + (size_t)l * 2816 * 1024, 2816, 1024, (bf16*)(WS + WS_WD1), nullptr, false, cscr, gw, NGW, lane, base);
            if (G != 256) {
            conv_job(IN(I_F2GU) + (size_t)l * 1024 * 5632, 1024, 5632, (bf16*)(WS + WS_WGU2), IN(I_F2N) + l * 1024, true, cscr, gw, NGW, lane, base);
            conv_job(IN(I_F2D) + (size_t)l * 2816 * 1024, 2816, 1024, (bf16*)(WS + WS_WD2), nullptr, false, cscr, gw, NGW, lane, base); }
            __syncthreads(); }
        if (l == 0) grid.sync(); else if (G != 256) SEAM();
#if REP_CONV > 1
        if (RUN) { ARGP(); TIDLANE(); int base = 0;
            conv_job(IN(I_F1GU) + (size_t)l * 1024 * 5632, 1024, 5632, (bf16*)(WS + WS_WGU1), IN(I_F1N) + l * 1024, true, cscr, gw, NGW, lane, base);
            conv_job(IN(I_F1D) + (size_t)l * 2816 * 1024, 2816, 1024, (bf16*)(WS + WS_WD1), nullptr, false, cscr, gw, NGW, lane, base);
            conv_job(IN(I_F2GU) + (size_t)l * 1024 * 5632, 1024, 5632, (bf16*)(WS + WS_WGU2), IN(I_F2N) + l * 1024, true, cscr, gw, NGW, lane, base);
            conv_job(IN(I_F2D) + (size_t)l * 2816 * 1024, 2816, 1024, (bf16*)(WS + WS_WD2), nullptr, false, cscr, gw, NGW, lane, base);
            __syncthreads(); }
        SEAM();
#endif
        for (int step = 0; step < 3; ++step) { const int hv = 3 * l + step;
            size_t rA, rB; int rK; float ralpha;
            if (step != 1) {
                if (G == 256) {
                    for (int pass = 0; pass < 2; ++pass) {
                        if (pass == 1 && bx < 44) { ARGP();
                            subset_sync((unsigned*)(WS + WS_SUB) + 64 * (2 * l + (step >> 1)), 44u, bx < 8);
                            pg8::Gemm g{HID, (const bf16*)(WS + (step == 0 ? WS_WD1 : WS_WD2)), MT, DM, DFF}; pg8::FfnOrder S; S.so.init(MP, DM, G, bx); S.mode = 1;
                            pg8::EpiRes E{hv == 0 ? IN(I_XS) - (size_t)MP * DM : (const float*)HRES, HRES, hb, SH(hv + 1), 0.5f};
                            pg8::gemm_phase<pg8::EpiRes, pg8::FfnOrder, false, true>(lds, g, S, E); }
                        { ARGP(); pg8::Gemm g{hb, (const bf16*)(WS + (step == 0 ? WS_WGU1 : WS_WGU2)), MT, 2 * DFF, DM}; pg8::FfnOrder S; S.so.init(MP, 2 * DFF, G, bx); S.mode = pass ? 2 : 0;
                            pg8::EpiGU E{HID, SH(hv)};
                            pg8::gemm_phase<pg8::EpiGU, pg8::FfnOrder, true, true>(lds, g, S, E); }
                    }
                    if (bx >= 84 && (step == 0 || l < 3)) { ARGP(); TIDLANE(); int base = 0; const int cgw = (bx - 84) * NWAVES + wave, cng = (256 - 84) * NWAVES; const int cl = step == 0 ? l : l + 1;
                        conv_job(IN(step == 0 ? I_F2GU : I_F1GU) + (size_t)cl * 1024 * 5632, 1024, 5632, (bf16*)(WS + (step == 0 ? WS_WGU2 : WS_WGU1)), IN(step == 0 ? I_F2N : I_F1N) + cl * 1024, true, cscr, cgw, cng, lane, base);
                        conv_job(IN(step == 0 ? I_F2D : I_F1D) + (size_t)cl * 2816 * 1024, 2816, 1024, (bf16*)(WS + (step == 0 ? WS_WD2 : WS_WD1)), nullptr, false, cscr, cgw, cng, lane, base);
                        __syncthreads(); }
                } else {
                    ARGP(); pg8::Gemm g{hb, (const bf16*)(WS + (step == 0 ? WS_WGU1 : WS_WGU2)), MT, 2 * DFF, DM}; pg8::StaticOrder S; S.init(MT, 2 * DFF, G, bx);
                    pg8::EpiGU E{HID, SH(hv)};
                    pg8::gemm_phase<pg8::EpiGU, pg8::StaticOrder, true, true>(lds, g, S, E); }
                SEAM();
#if REP_GU > 1
                if (RUN) { ARGP(); pg8::Gemm g{hb, (const bf16*)(WS + (step == 0 ? WS_WGU1 : WS_WGU2)), MT, 2 * DFF, DM}; pg8::StaticOrder S; S.init(MT, 2 * DFF, G, bx);
                    pg8::EpiGU E{HID, SH(hv)};
                    pg8::gemm_phase<pg8::EpiGU, pg8::StaticOrder, true, true>(lds, g, S, E); }
                SEAM();
#endif
                rA = WS_SCR; rB = step == 0 ? WS_WD1 : WS_WD2; rK = DFF; ralpha = 0.5f;
            } else if (l < 2) {
                if (RUN) { ARGP(); pg8::Gemm g{hb, (const bf16*)(WS + WS_WIN + (size_t)l * 4 * MiB), MT, 2048, DM}; pg8::StaticOrder S; S.init(MT, 2048, G, bx);
                    pg8::EpiWin E{Zb, SH(hv), SV(l)};
                    pg8::gemm_phase<pg8::EpiWin, pg8::StaticOrder, true, true>(lds, g, S, E); }
                SEAM();
#ifndef NO_SG
                for (int rep = 0; rep < REP_OTH; ++rep) { if (rep) SEAM(); ARGP(); sg::phase(lds, Zb, Pb, SV(l), IN(I_AVN) + l * 1024, (const bf16*)(WS + WS_WM) + (size_t)l * 2 * 8 * 128 * 128, (const float*)(WS + WS_BSG) + l * 2 * 8 * 128,
                                   OUTP + OUT_AV + (size_t)l * MS * 1024, vcu, G); }
#endif
                SEAM();
                rA = WS_KN; rB = WS_WOUT + (size_t)l * 2 * MiB; rK = DM; ralpha = 1.f;
            } else {
                const int j = l - 2;
                if (RUN) { ARGP(); pg8::Gemm g{hb, (const bf16*)(WS + WS_WDQ + (size_t)j * 512 * KiB), MT, 256, DM}; pg8::StaticOrder S; S.init(MT, 256, G, bx);
                    pg8::EpiQL E{QLb, SH(hv), SQ(j)};
                    pg8::gemm_phase<pg8::EpiQL, pg8::StaticOrder, true, true>(lds, g, S, E); }
                SEAM();
                for (int rep = 0; rep < REP_OTH; ++rep) { if (rep) SEAM(); ARGP(); int kq = 256; asm volatile("" : "+s"(kq));
                    pg8::Gemm g{QLb, (const bf16*)(WS + WS_WUQ + (size_t)j * 768 * KiB), MT, 1536, kq}; pg8::StaticOrder S; S.init(MT, 1536, G, bx);
                    pg8::EpiQ E{Qb, SQ(j), rope, QSCALE};
                    pg8::gemm_phase<pg8::EpiQ, pg8::StaticOrder, true, true>(lds, g, S, E); }
                SEAM();
#ifndef NO_ATT
                if (RUN) { ARGP(); att::phase(lds, Qb, KNb, KRb, VTb, Ob, vcu, G); }
#if REP_ATT > 1
                SEAM();
                if (RUN) { ARGP(); att::phase(lds, Qb, KNb, KRb, VTb, Ob, vcu, G); }
#endif
#endif
                SEAM();
                rA = WS_SCR + SCR_O; rB = WS_WO + (size_t)j * 2 * MiB; rK = DM; ralpha = 1.f;
            }
            if (RUN) { ARGP(); pg8::Gemm g{(const bf16*)(WS + rA), (const bf16*)(WS + rB), MT, DM, rK}; pg8::StaticOrder S; S.init((step != 1 && G == 256) ? MP : MT, DM, G, bx);
                pg8::EpiRes E{(hv == 0 && G == 256) ? IN(I_XP) : (const float*)HRES, HRES, hb, SH(hv + 1), ralpha};
                pg8::gemm_phase<pg8::EpiRes, pg8::StaticOrder, true, true>(lds, g, S, E); }
            SEAM();
#if REP_RES > 1
            if (RUN) { ARGP(); pg8::Gemm g{(const bf16*)(WS + rA), (const bf16*)(WS + rB), MT, DM, rK}; pg8::StaticOrder S; S.init(MT, DM, G, bx);
                pg8::EpiRes E{HRES, HRES, hb, nullptr, 0.f};
                pg8::gemm_phase<pg8::EpiRes, pg8::StaticOrder, true, true>(lds, g, S, E); }
            SEAM();
#endif
        }
        if (l == 1) { const int hv = 6;
            if (RUN) { ARGP(); pg8::Gemm g{hb, (const bf16*)(WS + WS_WDKV), MT, 256, DM}; pg8::StaticOrder S; S.init(MT, 256, G, bx);
                pg8::EpiLat E{KVRAW, SH(hv), SC()};
                pg8::gemm_phase<pg8::EpiLat, pg8::StaticOrder, true, true>(lds, g, S, E); }
            SEAM();
            for (int rep = 0; rep < REP_OTH; ++rep) { if (rep) SEAM(); ARGP(); TIDLANE();
                for (int m = gw; m < MT; m += NGW) {
                    const bool smp = m >= MP; const int ms = m - MP; const int pos = smp ? PAST + (ms & 63) : (m & (SEQ - 1));
                    const size_t kvrow = smp ? (size_t)MP + (size_t)(ms >> 6) * KVS + PAST + (ms & 63) : (size_t)m;
                    const float* kv = KVRAW + (size_t)m * 160; const float r = __builtin_amdgcn_rsqf(pg8::ld_stat(SC() + m) * (1.f / 128.f) + EPS);
                    const float c0 = kv[2 * lane] * r * IN(I_CKVN)[2 * lane], c1 = kv[2 * lane + 1] * r * IN(I_CKVN)[2 * lane + 1];
                    float* co = smp ? OUTP + OUT_CKVS + (size_t)ms * 128 : OUTP + OUT_CKVP + (size_t)m * 128;
                    co[2 * lane] = c0; co[2 * lane + 1] = c1;
                    ((unsigned*)(CKVALL + kvrow * 128))[lane] = cvtpk(c0, c1);
                    if (lane < 16) { const float x1 = kv[128 + lane], x2 = kv[144 + lane], c = rope[pos * 32 + lane], s = rope[pos * 32 + 16 + lane];
                        const float o1 = x1 * c - x2 * s, o2 = x2 * c + x1 * s;
                        float* ko = smp ? OUTP + OUT_KRS + (size_t)ms * 32 : OUTP + OUT_KRP + (size_t)m * 32;
                        ko[lane] = o1; ko[16 + lane] = o2;
                        const unsigned w = cvtpk(o1, o2); KRb[kvrow * 32 + lane] = (bf16)(w & 0xffffu); KRb[kvrow * 32 + 16 + lane] = (bf16)(w >> 16); }
                }
                for (int m = gw; m < 8 * PAST; m += NGW) { const int b = m / PAST, t = m % PAST; const size_t kvrow = (size_t)MP + (size_t)b * KVS + t;
                    const float* cc = IN(I_CCKV) + (size_t)m * 128; ((unsigned*)(CKVALL + kvrow * 128))[lane] = cvtpk(cc[2 * lane], cc[2 * lane + 1]);
                    if (lane < 16) { const float* ck = IN(I_CKR) + (size_t)m * 32; ((unsigned*)(KRb + kvrow * 32))[lane] = cvtpk(ck[2 * lane], ck[2 * lane + 1]); } }
            }
            SEAM();
            for (int rep = 0; rep < REP_OTH; ++rep) { if (rep) SEAM(); ARGP();
                { int kq = 128; asm volatile("" : "+s"(kq)); pg8::Gemm g{CKVALL, (const bf16*)(WS + WS_WUK), NKV, 1024, kq}; pg8::StaticOrder S; S.init(NKV, 1024, G, bx);
                  pg8::EpiPlain<1024> E{KNb};
                  pg8::gemm_phase<pg8::EpiPlain<1024>, pg8::StaticOrder, false, true>(lds, g, S, E); }
            }
            { ARGP();
                { int kq = 128; asm volatile("" : "+s"(kq)); pg8::Gemm g{(const bf16*)(WS + WS_WUV), CKVALL, 1024, NKV, kq}; pg8::StaticOrder S; S.init(1024, NKV, G, bx);
                  pg8::EpiPlain<NKV> E{VTb};
                  pg8::gemm_phase<pg8::EpiPlain<NKV>, pg8::StaticOrder, false, true>(lds, g, S, E); }
            }
            SEAM();
        }
    }
    if (RUN) { ARGP(); TIDLANE();
        for (int m = gw; m < MT; m += NGW) { const float r = __builtin_amdgcn_rsqf(pg8::ld_stat(SH(12) + m) * (1.f / 1024.f) + EPS);
#pragma unroll
            for (int j = 0; j < 4; ++j) { float* p = HRES + (size_t)m * DM + 256 * j + 4 * lane; const f32x4 v = *(const f32x4*)p, gn = *(const f32x4*)(IN(I_FN) + 256 * j + 4 * lane); *(f32x4*)p = v * r * gn; } }
    }
}

#undef G
#undef bx
#undef vcu
#undef gw
#undef NGW
#undef wave
#undef cscr
#undef stats
#undef scr
#undef rope
#undef hb
#undef IN
extern "C" void kernel_launch(void* const* d_in, const int* in_sizes, int n_in, void* d_out, int out_size, void* d_ws, size_t ws_size, hipStream_t stream) {
    static int grid = 0;
    if (grid == 0) {
        if (n_in != 26 || (size_t)out_size != OUT_END || ws_size < WS_END) { fprintf(stderr, "kernel_launch: unexpected shapes (n_in %d out %d ws %zu)\n", n_in, out_size, ws_size); grid = -1; return; }
        int dev = 0, cus = 0, per_cu = 0;
        hipGetDevice(&dev); hipDeviceGetAttribute(&cus, hipDeviceAttributeMultiprocessorCount, dev);
        if (hipFuncSetAttribute((const void*)mk_fwd, hipFuncAttributeMaxDynamicSharedMemorySize, LDS_BYTES) != hipSuccess) { fprintf(stderr, "kernel_launch: hipFuncSetAttribute failed\n"); grid = -1; return; }
        if (hipOccupancyMaxActiveBlocksPerMultiprocessor(&per_cu, (const void*)mk_fwd, NWAVES * 64, LDS_BYTES) != hipSuccess || per_cu < 1) { fprintf(stderr, "kernel_launch: occupancy query failed (%d)\n", per_cu); per_cu = 1; }
        (void)hipGetLastError();
        grid = cus * per_cu;
        fprintf(stderr, "kernel_launch: grid %d (%d CUs x %d)\n", grid, cus, per_cu);
    }
    if (grid < 0) return;
    if (hipMemsetAsync((char*)d_ws + WS_BAR, 0, 16 * KiB + 16 * 256, stream) != hipSuccess) { fprintf(stderr, "kernel_launch: memset failed\n"); return; }
    Args a{};
    for (int i = 0; i < 26; ++i) a.in[i] = (const float*)d_in[i];
    a.out = (float*)d_out; a.ws = (unsigned char*)d_ws; a.ph_lo = 0; a.ph_hi = 1 << 20;
    void* params[] = {&a};
    hipError_t e = hipLaunchCooperativeKernel((const void*)mk_fwd, dim3(grid), dim3(NWAVES * 64), params, LDS_BYTES, stream);
    if (e != hipSuccess) fprintf(stderr, "kernel_launch: cooperative launch failed: %s (grid %d)\n", hipGetErrorString(e), grid);
}
```

```cpp
#include <hip/hip_runtime.h>
#include <hip/hip_cooperative_groups.h>
#include <cstdio>
#include <cstdint>
namespace cg = cooperative_groups;
__device__ __forceinline__ int opaque_tid() { int t = threadIdx.x; asm volatile("" : "+v"(t)); return t; }
namespace pg8 {
#define PG8_LAS __attribute__((address_space(3)))
typedef unsigned short bf16_t;
typedef short bf16x8 __attribute__((ext_vector_type(8)));
typedef float f32x4 __attribute__((ext_vector_type(4)));
typedef unsigned u32x4 __attribute__((ext_vector_type(4)));
constexpr int BM = 256, BK = 64, HALF = 128, HTB = HALF * BK * 2  , STAGE_BYTES = 8 * HTB, NXCD = 8, WGM = 8;

__host__ __device__ __forceinline__ int lds_byte(int r, int c) { const int st = (r >> 4) * 2 + (c >> 5), rr = r & 15, cc = c & 31, ob = rr * 64 + cc * 2; return st * 1024 + (ob ^ (((ob >> 9) & 1) << 5)); }
__host__ __device__ __forceinline__ void stage_rc(int b, int& R, int& C) { const int st = b / 1024, sb = b % 1024, swz = sb ^ (((sb >> 9) & 1) << 5); R = (st >> 1) * 16 + swz / 64; C = (st & 1) * 32 + (swz % 64) / 2; }
__host__ __device__ __forceinline__ int perm32(int rho) { const int n = rho >> 4, i = rho & 15; return 8 * (i >> 2) + 4 * n + (i & 3); }

struct Unit { int pm, pn; };
struct Gemm { const bf16_t* A; const bf16_t* Bt; int M, N, K; };

struct StaticOrder {
    int nM, nN, nwg, G, c;
    __host__ __device__ void init(int M, int N, int G_, int c_) { nM = M / BM; nN = N / BM; nwg = nM * nN; G = G_; c = c_; }
    __host__ __device__ bool next(int i, Unit& u) const { return at(i * G + c, u); }
    __host__ __device__ bool at(int L, Unit& u) const {
        if (L >= nwg) return false;
        int wgid = (int)L; { const int q = nwg / NXCD, r = nwg % NXCD, xcd = wgid % NXCD, off = wgid / NXCD; wgid = (xcd < r ? xcd * (q + 1) : r * (q + 1) + (xcd - r) * q) + off; }
        const int nig = WGM * nN, gid = wgid / nig, fm = gid * WGM, gsz = (nM - fm) < WGM ? (nM - fm) : WGM;
        u.pm = fm + ((wgid % nig) % gsz); u.pn = (wgid % nig) / gsz; return true;
    }
    __device__ __forceinline__ void a_ready(const Unit&) const {}
    __device__ __forceinline__ void done(const Unit&) const {}
};

struct FfnOrder {
    StaticOrder so; int mode;
    __device__ __forceinline__ bool next(int i, Unit& u) const {
        const int c = so.c;
        if (mode == 0) { if (i > 0 || c >= 44) return false; u.pm = 128 + c / 22; u.pn = c % 22; return true; }
        if (mode == 1) { if (i > 0 || c >= 8) return false; u.pm = 128 + (c >> 2); u.pn = c & 3; return true; }
        int L;
        if (c < 8) { if (i >= 6) return false; L = i * so.G + c; }
        else if (i < 11) L = i * so.G + c;
        else if (i == 11 && c >= 44 && c < 84) { const int k = c - 44; L = (6 + (k >> 3)) * so.G + (k & 7); }
        else return false;
        return so.at(L, u);
    }
    __device__ __forceinline__ void a_ready(const Unit&) const {}
    __device__ __forceinline__ void done(const Unit&) const {}
};

typedef float f32x2 __attribute__((ext_vector_type(2)));
__device__ __forceinline__ f32x2 gelu_pk(f32x2 v) {
    const f32x2 av = __builtin_elementwise_abs(v), d = av * 0.2316418882f + 1.0f;
    f32x2 t; t.x = __builtin_amdgcn_rcpf(d.x); t.y = __builtin_amdgcn_rcpf(d.y);
    f32x2 q = t * 0.5307027145f + (-0.7265760135f); q = q * t + 0.7107068705f; q = q * t + (-0.142248368f); q = q * t + 0.127414796f; q = q * t;
    const f32x2 s = (v * v) * (-0.72134752044f);
    f32x2 e; e.x = __builtin_amdgcn_exp2f(s.x); e.y = __builtin_amdgcn_exp2f(s.y);
    const f32x2 m = v * (q * e), r = v - m;
    f32x2 o; o.x = v.x < 0.f ? m.x : r.x; o.y = v.y < 0.f ? m.y : r.y; return o;
}
typedef float f32x2_t __attribute__((ext_vector_type(2))); typedef __bf16 bf16x2_t __attribute__((ext_vector_type(2)));
typedef unsigned u32x2 __attribute__((ext_vector_type(2)));
__device__ __forceinline__ unsigned cvtpk(float lo, float hi) { f32x2_t v = {lo, hi}; bf16x2_t b = __builtin_convertvector(v, bf16x2_t); return __builtin_bit_cast(unsigned, b); }
__device__ __forceinline__ float ld_stat(const float* p) { return __hip_atomic_load(p, __ATOMIC_RELAXED, __HIP_MEMORY_SCOPE_AGENT); }
__device__ __forceinline__ void add_stat(float* p, float v) { (void)__hip_atomic_fetch_add(p, v, __ATOMIC_RELAXED, __HIP_MEMORY_SCOPE_AGENT); }
__device__ __forceinline__ float rstd_of(const float* ss, int row, float invd) { return __builtin_amdgcn_rsqf(ld_stat(ss + row) * invd + 1e-6f); }
__device__ __forceinline__ float red_fq(float s) { s += __shfl_xor(s, 16); s += __shfl_xor(s, 32); return s; }

struct EpiGU { static constexpr bool PERM = true, AFTER_DRAIN = false;
    bf16_t* H; const float* ss;
    __device__ __forceinline__ void operator()(const f32x4 (&acc)[2][2][4][2], const Unit& u, int wr, int wc, int fr, int fq) const {
        const int row0 = u.pm * BM + wr * 64 + fr, col0 = u.pn * 128 + wc * 32 + 8 * fq;
#pragma unroll
        for (int ai = 0; ai < 2; ++ai)
#pragma unroll
            for (int m = 0; m < 4; ++m) { const int row = row0 + ai * HALF + m * 16; const float r = rstd_of(ss, row, 1.f / 1024.f);
                float o[8];
#pragma unroll
                for (int n = 0; n < 2; ++n)
#pragma unroll
                    for (int j = 0; j < 4; ++j) { const float g = acc[ai][0][m][n][j] * r, uu = acc[ai][1][m][n][j] * r;
                        o[n * 4 + j] = g * uu * __builtin_amdgcn_rcpf(1.f + __builtin_amdgcn_exp2f(-1.4426950408889634f * g)); }
                u32x4 w; w.x = cvtpk(o[0], o[1]); w.y = cvtpk(o[2], o[3]); w.z = cvtpk(o[4], o[5]); w.w = cvtpk(o[6], o[7]);
                *(u32x4*)(H + (size_t)row * 2816 + col0) = w; }
    }
};
struct EpiRes { static constexpr bool PERM = true, AFTER_DRAIN = false;
    const float* base; float* h; bf16_t* hb; float* ssn; float alpha;
    __device__ __forceinline__ void operator()(const f32x4 (&acc)[2][2][4][2], const Unit& u, int wr, int wc, int fr, int fq) const {
        const int row0 = u.pm * BM + wr * 64 + fr, col0 = u.pn * BM + wc * 32 + 8 * fq;
#pragma unroll
        for (int ai = 0; ai < 2; ++ai)
#pragma unroll
            for (int m = 0; m < 4; ++m) { const int row = row0 + ai * HALF + m * 16; float s = 0.f;
#pragma unroll
                for (int bj = 0; bj < 2; ++bj) { const size_t off = (size_t)row * 1024 + col0 + bj * HALF;
                    f32x4 v0 = *(const f32x4*)(base + off), v1 = *(const f32x4*)(base + off + 4);
                    v0 = v0 + acc[ai][bj][m][0] * alpha; v1 = v1 + acc[ai][bj][m][1] * alpha;
                    *(f32x4*)(h + off) = v0; *(f32x4*)(h + off + 4) = v1;
                    u32x4 w; w.x = cvtpk(v0[0], v0[1]); w.y = cvtpk(v0[2], v0[3]); w.z = cvtpk(v1[0], v1[1]); w.w = cvtpk(v1[2], v1[3]); *(u32x4*)(hb + off) = w;
                    s += (v0[0] * v0[0] + v0[1] * v0[1]) + (v0[2] * v0[2] + v0[3] * v0[3]) + (v1[0] * v1[0] + v1[1] * v1[1]) + (v1[2] * v1[2] + v1[3] * v1[3]); }
                if (ssn) { s = red_fq(s); if (fq == 0) add_stat(ssn + row, s); }
                asm volatile("" ::: "memory"); }
    }
};
struct EpiWin { static constexpr bool PERM = true, AFTER_DRAIN = false;
    bf16_t* Z; const float* ss; float* ssv;
    __device__ __forceinline__ void operator()(const f32x4 (&acc)[2][2][4][2], const Unit& u, int wr, int wc, int fr, int fq) const {
        const int row0 = u.pm * BM + wr * 64 + fr, col0 = u.pn * BM + wc * 32 + 8 * fq;
#pragma unroll
        for (int ai = 0; ai < 2; ++ai)
#pragma unroll
            for (int m = 0; m < 4; ++m) { const int row = row0 + ai * HALF + m * 16; const float r = rstd_of(ss, row, 1.f / 1024.f); float s = 0.f;
#pragma unroll
                for (int bj = 0; bj < 2; ++bj) { const f32x4 v0 = acc[ai][bj][m][0] * r, v1 = acc[ai][bj][m][1] * r;
                    const f32x2 a = gelu_pk((f32x2){v0[0], v0[1]}), b = gelu_pk((f32x2){v0[2], v0[3]}), c = gelu_pk((f32x2){v1[0], v1[1]}), d = gelu_pk((f32x2){v1[2], v1[3]});
                    s += (a.x * a.x + a.y * a.y) + (b.x * b.x + b.y * b.y) + (c.x * c.x + c.y * c.y) + (d.x * d.x + d.y * d.y);
                    u32x4 w; w.x = cvtpk(a.x, a.y); w.y = cvtpk(b.x, b.y); w.z = cvtpk(c.x, c.y); w.w = cvtpk(d.x, d.y);
                    *(u32x4*)(Z + (size_t)row * 2048 + col0 + bj * HALF) = w; }
                if (u.pn >= 4) { s = red_fq(s); if (fq == 0) add_stat(ssv + row, s); } }
    }
};
struct EpiQL { static constexpr bool PERM = true, AFTER_DRAIN = false;
    bf16_t* QL; const float* ss; float* ssq;
    __device__ __forceinline__ void operator()(const f32x4 (&acc)[2][2][4][2], const Unit& u, int wr, int wc, int fr, int fq) const {
        const int row0 = u.pm * BM + wr * 64 + fr, col0 = wc * 32 + 8 * fq;
#pragma unroll
        for (int ai = 0; ai < 2; ++ai)
#pragma unroll
            for (int m = 0; m < 4; ++m) { const int row = row0 + ai * HALF + m * 16; const float r = rstd_of(ss, row, 1.f / 1024.f); float s = 0.f;
#pragma unroll
                for (int bj = 0; bj < 2; ++bj) { const f32x4 v0 = acc[ai][bj][m][0] * r, v1 = acc[ai][bj][m][1] * r;
                    s += (v0[0] * v0[0] + v0[1] * v0[1]) + (v0[2] * v0[2] + v0[3] * v0[3]) + (v1[0] * v1[0] + v1[1] * v1[1]) + (v1[2] * v1[2] + v1[3] * v1[3]);
                    u32x4 w; w.x = cvtpk(v0[0], v0[1]); w.y = cvtpk(v0[2], v0[3]); w.z = cvtpk(v1[0], v1[1]); w.w = cvtpk(v1[2], v1[3]);
                    *(u32x4*)(QL + (size_t)row * 256 + col0 + bj * HALF) = w; }
                s = red_fq(s); if (fq == 0) add_stat(ssq + row, s); }
    }
};
struct EpiQ { static constexpr bool PERM = true, AFTER_DRAIN = false;
    bf16_t* Q; const float* ssq; const float* rope; float qscale;
    __device__ __forceinline__ void operator()(const f32x4 (&acc)[2][2][4][2], const Unit& u, int wr, int wc, int fr, int fq) const {
        const int row0 = u.pm * BM + wr * 64 + fr, col0 = u.pn * BM + wc * 32 + 8 * fq; const int i0 = 8 * (fq & 1); const float sgn = fq < 2 ? -1.f : 1.f;
#pragma unroll
        for (int ai = 0; ai < 2; ++ai)
#pragma unroll
            for (int m = 0; m < 4; ++m) { const int row = row0 + ai * HALF + m * 16; const float r = rstd_of(ssq, row, 1.f / 256.f) * qscale;
                const int pos = row < 32768 ? (row & 8191) : 2048 + ((row - 32768) & 63);
#pragma unroll
                for (int bj = 0; bj < 2; ++bj) { const int grp = u.pn * 8 + bj * 4 + wc;
                    f32x4 a = acc[ai][bj][m][0] * r, b = acc[ai][bj][m][1] * r;
                    if (grp % 3 == 2) { f32x4 pa, pb;
#pragma unroll
                        for (int j = 0; j < 4; ++j) { pa[j] = __shfl_xor(a[j], 32); pb[j] = __shfl_xor(b[j], 32); }
                        const float* rp = rope + pos * 32 + i0;
                        const f32x4 c0 = *(const f32x4*)rp, c1 = *(const f32x4*)(rp + 4), s0 = *(const f32x4*)(rp + 16), s1 = *(const f32x4*)(rp + 20);
                        a = a * c0 + pa * s0 * sgn; b = b * c1 + pb * s1 * sgn; }
                    u32x4 w; w.x = cvtpk(a[0], a[1]); w.y = cvtpk(a[2], a[3]); w.z = cvtpk(b[0], b[1]); w.w = cvtpk(b[2], b[3]);
                    *(u32x4*)(Q + (size_t)row * 1536 + col0 + bj * HALF) = w; }
                asm volatile("" ::: "memory"); }
    }
};
struct EpiLat { static constexpr bool PERM = false, AFTER_DRAIN = false;
    float* KV; const float* ss; float* ssc;
    __device__ __forceinline__ void operator()(const f32x4 (&acc)[2][2][4][2], const Unit& u, int wr, int wc, int fr, int fq) const {
        const int row0 = u.pm * BM + wr * 64 + fr, col0 = wc * 32 + 4 * fq;
#pragma unroll
        for (int ai = 0; ai < 2; ++ai)
#pragma unroll
            for (int m = 0; m < 4; ++m) { const int row = row0 + ai * HALF + m * 16; const float r = rstd_of(ss, row, 1.f / 1024.f); float s = 0.f;
#pragma unroll
                for (int bj = 0; bj < 2; ++bj)
#pragma unroll
                    for (int n = 0; n < 2; ++n) { const int col = col0 + bj * HALF + n * 16;
                        if (col < 160) { const f32x4 v = acc[ai][bj][m][n] * r; *(f32x4*)(KV + (size_t)row * 160 + col) = v;
                            if (col < 128) s += (v[0] * v[0] + v[1] * v[1]) + (v[2] * v[2] + v[3] * v[3]); } }
                s = red_fq(s); if (fq == 0) add_stat(ssc + row, s); }
    }
};
template <int LDC> struct EpiPlain { static constexpr bool PERM = true, AFTER_DRAIN = false;
    bf16_t* O;
    __device__ __forceinline__ void operator()(const f32x4 (&acc)[2][2][4][2], const Unit& u, int wr, int wc, int fr, int fq) const {
        const int row0 = u.pm * BM + wr * 64 + fr, col0 = u.pn * BM + wc * 32 + 8 * fq;
#pragma unroll
        for (int ai = 0; ai < 2; ++ai)
#pragma unroll
            for (int m = 0; m < 4; ++m) { const int row = row0 + ai * HALF + m * 16;
#pragma unroll
                for (int bj = 0; bj < 2; ++bj) { const f32x4 v0 = acc[ai][bj][m][0], v1 = acc[ai][bj][m][1];
                    u32x4 w; w.x = cvtpk(v0[0], v0[1]); w.y = cvtpk(v0[2], v0[3]); w.z = cvtpk(v1[0], v1[1]); w.w = cvtpk(v1[2], v1[3]);
                    *(u32x4*)(O + (size_t)row * LDC + col0 + bj * HALF) = w; } }
    }
};
template <class Epi, class Sched, bool ALIGN_EPI = false, bool SP2 = false>
__device__ __forceinline__ void gemm_phase(PG8_LAS unsigned char* lds, const Gemm g, const Sched& S, const Epi& E) {
    const int tid = opaque_tid(), wid = __builtin_amdgcn_readfirstlane(tid >> 6), lane = tid & 63, wr = wid >> 2, wc = wid & 3, fr = lane & 15, fq = lane >> 4;
    const int K = g.K, nt = K / BK;
    unsigned voffA[2], voffB[2];
#pragma unroll
    for (int i = 0; i < 2; ++i) { int R, C; stage_rc(tid * 16 + i * 8192, R, C); const int Rb = Epi::PERM ? ((R & ~31) + perm32(R & 31)) : R;
        voffA[i] = (unsigned)(R * K + C) * 2u; voffB[i] = (unsigned)(Rb * K + C) * 2u; }
    const size_t kstep = (size_t)(BK * 2);
    const size_t hstep = (size_t)HALF * K * 2;
    const size_t tstep = 2 * hstep;
    const unsigned ldsw = (unsigned)wid * 1024u;
    const int aoff = lds_byte(wr * 64 + fr, fq * 8), boff = lds_byte(wc * 32 + fr, fq * 8);
#define PG8_SA(b, h) (((b) * 2 + (h)) * HTB)
#define PG8_SB(b, h) ((4 + (b) * 2 + (h)) * HTB)
#define PG8_STAGE(bufoff, gbase, voff) do { _Pragma("unroll") for (int _i = 0; _i < 2; ++_i) \
        __builtin_amdgcn_global_load_lds((const unsigned*)((const char*)(gbase) + (voff)[_i]), (PG8_LAS unsigned*)(lds + (bufoff) + ldsw + _i * 8192), 16, 0, 0); } while (0)
#define PG8_LDA(dst, b, h) do { _Pragma("unroll") for (int m = 0; m < 4; ++m) _Pragma("unroll") for (int k = 0; k < 2; ++k) dst[m][k] = *(const PG8_LAS bf16x8*)(lds + PG8_SA(b, h) + aoff + m * 2048 + k * 1024); } while (0)
#define PG8_LDB(dst, b, h) do { _Pragma("unroll") for (int n = 0; n < 2; ++n) _Pragma("unroll") for (int k = 0; k < 2; ++k) dst[n][k] = *(const PG8_LAS bf16x8*)(lds + PG8_SB(b, h) + boff + n * 2048 + k * 1024); } while (0)
#define PG8_MMA(ai, bj, At, Bt) do { __builtin_amdgcn_s_setprio(1); _Pragma("unroll") for (int m = 0; m < 4; ++m) _Pragma("unroll") for (int n = 0; n < 2; ++n) _Pragma("unroll") for (int k = 0; k < 2; ++k) \
        acc[ai][bj][m][n] = __builtin_amdgcn_mfma_f32_16x16x32_bf16(Bt[n][k], At[m][k], acc[ai][bj][m][n], 0, 0, 0); __builtin_amdgcn_s_setprio(0); } while (0)
#define PG8_WAIT_V(n) asm volatile("s_waitcnt vmcnt(" #n ")" ::: "memory")
#define PG8_WAIT_L(n) asm volatile("s_waitcnt lgkmcnt(" #n ")" ::: "memory")
#define PG8_BAR __builtin_amdgcn_s_barrier()
#define PG8_SCHED __builtin_amdgcn_sched_barrier(0)
    Unit cur, nxt; int ui = 0;
    if (!S.next(0, cur)) return;
    f32x4 acc[2][2][4][2];
#pragma unroll
    for (int a = 0; a < 2; ++a)
#pragma unroll
        for (int b = 0; b < 2; ++b)
#pragma unroll
            for (int m = 0; m < 4; ++m)
#pragma unroll
                for (int n = 0; n < 2; ++n) acc[a][b][m][n] = (f32x4){0.f, 0.f, 0.f, 0.f};
    bf16x8 At[4][2], B0[2][2], B1[2][2];
    const char* cA = (const char*)g.A + (size_t)cur.pm * tstep; const char* cB = (const char*)g.Bt + (size_t)cur.pn * tstep;
    S.a_ready(cur);
    if constexpr (SP2) {
        PG8_STAGE(PG8_SB(0, 0), cB, voffB); PG8_STAGE(PG8_SB(0, 1), cB + hstep, voffB); PG8_STAGE(PG8_SA(0, 0), cA, voffA); PG8_STAGE(PG8_SA(0, 1), cA + hstep, voffA);
        if (wr == 1) PG8_BAR;
        PG8_WAIT_V(2); PG8_BAR;
        PG8_STAGE(PG8_SB(1, 0), cB + kstep, voffB); PG8_STAGE(PG8_SA(1, 0), cA + kstep, voffA); PG8_STAGE(PG8_SB(1, 1), cB + hstep + kstep, voffB);
        PG8_WAIT_V(6); PG8_BAR;
    } else {
        PG8_STAGE(PG8_SB(0, 0), cB, voffB); PG8_STAGE(PG8_SA(0, 0), cA, voffA); PG8_STAGE(PG8_SB(0, 1), cB + hstep, voffB); PG8_STAGE(PG8_SA(0, 1), cA + hstep, voffA);
        if (wr == 1) PG8_BAR;
        PG8_WAIT_V(4); PG8_BAR;
        PG8_STAGE(PG8_SB(1, 0), cB + kstep, voffB); PG8_STAGE(PG8_SA(1, 0), cA + kstep, voffA); PG8_STAGE(PG8_SB(1, 1), cB + hstep + kstep, voffB);
        PG8_WAIT_V(6); PG8_BAR;
    }
    for (;;) {
        const bool has_next = S.next(ui + 1, nxt);
        const char* nA = has_next ? (const char*)g.A + (size_t)nxt.pm * tstep : cA; const char* nB = has_next ? (const char*)g.Bt + (size_t)nxt.pn * tstep : cB;
        for (int t = 0; t < nt; t += 2) {
            const bool last = (t == nt - 2);
            const char* a1 = cA + (size_t)(t + 1) * kstep;
            const char* a2 = last ? nA : cA + (size_t)(t + 2) * kstep; const char* b2 = last ? nB : cB + (size_t)(t + 2) * kstep;
            const char* a3 = a2 + kstep; const char* b3 = b2 + kstep;
            if (last && has_next) S.a_ready(nxt);
            if constexpr (SP2) {
            PG8_LDB(B0, 0, 0); PG8_LDB(B1, 0, 1); PG8_SCHED; PG8_LDA(At, 0, 0); PG8_STAGE(PG8_SA(1, 1), a1 + hstep, voffA);
            PG8_WAIT_V(8); PG8_WAIT_L(0); PG8_BAR; PG8_MMA(0, 0, At, B0); PG8_MMA(0, 1, At, B1); PG8_BAR; PG8_SCHED;
            PG8_LDA(At, 0, 1); PG8_STAGE(PG8_SB(0, 0), b2, voffB); PG8_STAGE(PG8_SB(0, 1), b2 + hstep, voffB); PG8_STAGE(PG8_SA(0, 0), a2, voffA);
            PG8_WAIT_V(8); PG8_WAIT_L(0); PG8_BAR; PG8_MMA(1, 0, At, B0); PG8_MMA(1, 1, At, B1); PG8_BAR; PG8_SCHED;
            PG8_LDB(B0, 1, 0); PG8_LDB(B1, 1, 1); PG8_SCHED; PG8_LDA(At, 1, 0); PG8_STAGE(PG8_SA(0, 1), a2 + hstep, voffA);
            PG8_WAIT_V(8); PG8_WAIT_L(0); PG8_BAR; PG8_MMA(0, 0, At, B0); PG8_MMA(0, 1, At, B1); PG8_BAR; PG8_SCHED;
            PG8_LDA(At, 1, 1); PG8_STAGE(PG8_SB(1, 0), b3, voffB); PG8_STAGE(PG8_SB(1, 1), b3 + hstep, voffB); PG8_STAGE(PG8_SA(1, 0), a3, voffA);
            PG8_WAIT_V(8); PG8_WAIT_L(0); PG8_BAR; PG8_MMA(1, 0, At, B0); PG8_MMA(1, 1, At, B1); PG8_BAR; PG8_SCHED;
            } else {
            PG8_LDB(B0, 0, 0); PG8_SCHED; PG8_LDA(At, 0, 0); PG8_STAGE(PG8_SA(1, 1), a1 + hstep, voffA);
            PG8_WAIT_L(8); PG8_BAR; PG8_WAIT_L(0); PG8_MMA(0, 0, At, B0); PG8_BAR; PG8_SCHED;
            PG8_LDB(B1, 0, 1); PG8_STAGE(PG8_SB(0, 0), b2, voffB);
            PG8_BAR; PG8_WAIT_L(0); PG8_MMA(0, 1, At, B1); PG8_BAR;
            PG8_LDA(At, 0, 1); PG8_STAGE(PG8_SA(0, 0), a2, voffA);
            PG8_BAR; PG8_WAIT_L(0); PG8_MMA(1, 0, At, B0); PG8_BAR; PG8_SCHED;
            PG8_STAGE(PG8_SB(0, 1), b2 + hstep, voffB);
            PG8_WAIT_V(6); PG8_BAR; PG8_MMA(1, 1, At, B1); PG8_BAR;
            PG8_LDB(B0, 1, 0); PG8_SCHED; PG8_LDA(At, 1, 0); PG8_STAGE(PG8_SA(0, 1), a2 + hstep, voffA);
            PG8_WAIT_L(8); PG8_BAR; PG8_WAIT_L(0); PG8_MMA(0, 0, At, B0); PG8_BAR; PG8_SCHED;
            PG8_LDB(B1, 1, 1); PG8_STAGE(PG8_SB(1, 0), b3, voffB);
            PG8_BAR; PG8_WAIT_L(0); PG8_MMA(0, 1, At, B1); PG8_BAR;
            PG8_LDA(At, 1, 1); PG8_STAGE(PG8_SA(1, 0), a3, voffA);
            PG8_BAR; PG8_WAIT_L(0); PG8_MMA(1, 0, At, B0); PG8_BAR; PG8_SCHED;
            PG8_STAGE(PG8_SB(1, 1), b3 + hstep, voffB);
            PG8_WAIT_V(6); PG8_BAR; PG8_MMA(1, 1, At, B1); PG8_BAR;
            }
        }
        if constexpr (ALIGN_EPI) { if (wr == 0) PG8_BAR; }
        if constexpr (!Epi::AFTER_DRAIN) { E(acc, cur, wr, wc, fr, fq); S.done(cur); }
        if (!has_next) break;
#pragma unroll
        for (int a = 0; a < 2; ++a)
#pragma unroll
            for (int b = 0; b < 2; ++b)
#pragma unroll
                for (int m = 0; m < 4; ++m)
#pragma unroll
                    for (int n = 0; n < 2; ++n) acc[a][b][m][n] = (f32x4){0.f, 0.f, 0.f, 0.f};
        cur = nxt; cA = nA; cB = nB; ++ui;
        if constexpr (ALIGN_EPI) { if (wr == 1) PG8_BAR; }
    }
    PG8_WAIT_V(0);
    if constexpr (!ALIGN_EPI) { if (wr == 0) PG8_BAR; }
    PG8_BAR;
    if constexpr (Epi::AFTER_DRAIN) { E.fused(acc, cur, wr, wc, fr, fq, lds, wid, lane); S.done(cur); }
#undef PG8_SA
#undef PG8_SB
#undef PG8_STAGE
#undef PG8_LDA
#undef PG8_LDB
#undef PG8_MMA
#undef PG8_WAIT_V
#undef PG8_WAIT_L
#undef PG8_BAR
#undef PG8_SCHED
}
}

constexpr int MP = 32768, MS = 512, MT = MP + MS, DM = 1024, DFF = 2816, NKV = 49664, SEQ = 8192, PAST = 2048, KVS = PAST + 64;
constexpr float EPS = 1e-6f;
constexpr float QSCALE = 0.10206207261596577f * 1.4426950408889634f;
#define GAS __attribute__((address_space(1)))
#define LAS __attribute__((address_space(3)))
typedef unsigned short bf16;
typedef float f32x4 __attribute__((ext_vector_type(4)));
typedef float f32x16 __attribute__((ext_vector_type(16)));
typedef short bf16x8 __attribute__((ext_vector_type(8)));
typedef short s16x4 __attribute__((ext_vector_type(4)));
typedef unsigned u32x4 __attribute__((ext_vector_type(4)));
typedef unsigned u32x2 __attribute__((ext_vector_type(2)));
using pg8::cvtpk;

constexpr size_t MiB = 1u << 20, KiB = 1u << 10;
constexpr size_t WS_STATS = 0;
constexpr size_t WS_BSG = 3 * MiB;
constexpr size_t WS_BAR = 3 * MiB + 512 * KiB;
constexpr size_t WS_SUB = WS_BAR + 16 * KiB;
constexpr size_t WS_ROPE = 4 * MiB;
constexpr size_t WS_WIN = 5 * MiB;
constexpr size_t WS_WOUT = 13 * MiB;
constexpr size_t WS_WM = 17 * MiB;
constexpr size_t WS_WDKV = 18 * MiB;
constexpr size_t WS_WUK = 18 * MiB + 512 * KiB;
constexpr size_t WS_WUV = 18 * MiB + 768 * KiB;
constexpr size_t WS_WDQ = 19 * MiB;
constexpr size_t WS_WUQ = 20 * MiB;
constexpr size_t WS_WO = 21 * MiB + 512 * KiB;
constexpr size_t WS_WGU1 = 26 * MiB, WS_WD1 = 37 * MiB, WS_WGU2 = 42 * MiB + 512 * KiB, WS_WD2 = 53 * MiB + 512 * KiB;
constexpr size_t WS_HB = 59 * MiB;
constexpr size_t WS_SCR = 124 * MiB;
constexpr size_t WS_KN = 303 * MiB;
constexpr size_t WS_VT = 400 * MiB;
constexpr size_t WS_KR = 497 * MiB;
constexpr size_t WS_END = 501 * MiB;
constexpr size_t SCR_CKVALL = 32 * MiB, SCR_O = (size_t)MT * 1536 * 2, SCR_QL = SCR_O + (size_t)MT * 1024 * 2;
static_assert(SCR_QL + (size_t)MT * 256 * 2 <= 179 * MiB, "scratch");
constexpr size_t OUT_Y = 0, OUT_CKVP = (size_t)MT * DM, OUT_KRP = OUT_CKVP + (size_t)MP * 128, OUT_CKVS = OUT_KRP + (size_t)MP * 32, OUT_KRS = OUT_CKVS + (size_t)MS * 128,
                 OUT_AV = OUT_KRS + (size_t)MS * 32, OUT_END = OUT_AV + (size_t)2 * MS * 1024;

constexpr int LDS_BYTES = 147456;
constexpr int NWAVES = 8;
#ifndef REP_ATT
#define REP_ATT 1
#endif
#ifndef REP_CONV
#define REP_CONV 1
#endif
#ifndef REP_OTH
#define REP_OTH 1
#endif
#ifndef REP_PRO
#define REP_PRO 1
#endif
#ifndef REP_RES
#define REP_RES 1
#endif
#ifndef REP_GU
#define REP_GU 1
#endif
#define LDS_WAIT() asm volatile("s_waitcnt lgkmcnt(0)" ::: "memory")
constexpr int XB_LDS_OFF = 147456 - 64;
constexpr int PTR_OFF = 131072;
__device__ __forceinline__ const void* ldptr(LAS unsigned char* lds, int i) { const volatile LAS unsigned* p = (const volatile LAS unsigned*)(lds + PTR_OFF) + 2 * i; const unsigned lo = __builtin_amdgcn_readfirstlane(p[0]), hi = __builtin_amdgcn_readfirstlane(p[1]); return (const void*)(((unsigned long long)hi << 32) | lo); }

struct Args { const float* in[26]; float* out; unsigned char* ws; int ph_lo, ph_hi; };
enum { I_XP = 0, I_XS, I_CCKV, I_CKR, I_F1N, I_F1GU, I_F1D, I_MIXN, I_F2N, I_F2GU, I_F2D, I_AWIN, I_AVN, I_AWS, I_ABS, I_AWOUT, I_KVN, I_WDKV, I_CKVN, I_WUK, I_WUV, I_BWDQ, I_BQN, I_BWUQ, I_BWO, I_FN };

__device__ __forceinline__ float wave_sum(float v) {
#pragma unroll
    for (int o = 1; o < 64; o <<= 1) v += __shfl_xor(v, o);
    return v;
}

__device__ __forceinline__ void tr_item(const float* W, int N, bf16* WT, int ldk, const float* gain, LAS float* scr, int k0, int n0, int drow0, int lane) {
#pragma unroll 8
    for (int i = 0; i < 32; ++i) { const int kk = 2 * i + (lane >> 5); float w = W[(size_t)(k0 + kk) * N + n0 + (lane & 31)]; if (gain) w *= gain[k0 + kk]; scr[kk * 33 + (lane & 31)] = w; }
    LDS_WAIT(); asm volatile("" ::: "memory");
    const int c = lane & 7;
#pragma unroll
    for (int j = 0; j < 4; ++j) { const int n = (lane >> 3) + 8 * j; const LAS float* s = scr + (8 * c) * 33 + n;
        u32x4 o; o.x = cvtpk(s[0 * 33], s[1 * 33]); o.y = cvtpk(s[2 * 33], s[3 * 33]); o.z = cvtpk(s[4 * 33], s[5 * 33]); o.w = cvtpk(s[6 * 33], s[7 * 33]);
        *(u32x4*)(WT + (size_t)(drow0 + n) * ldk + k0 + 8 * c) = o; }
    LDS_WAIT(); asm volatile("" ::: "memory");
}
__device__ __forceinline__ void tr_item64(const float* W, int N, bf16* WT, int ldk, const float* gain, LAS float* scr, int k0, int n0, int drow0, int lane) {
    const int rr = lane >> 4, c4 = lane & 15;
    f32x4 v[16];
#pragma unroll
    for (int i = 0; i < 16; ++i) v[i] = *(const f32x4*)(W + (size_t)(k0 + 4 * i + rr) * N + n0 + 4 * c4);
#pragma unroll
    for (int i = 0; i < 16; ++i) { const int row = 4 * i + rr; const float g = gain ? gain[k0 + row] : 1.f; LAS float* s = scr + row * 65 + 4 * c4;
        s[0] = v[i][0] * g; s[1] = v[i][1] * g; s[2] = v[i][2] * g; s[3] = v[i][3] * g; }
    LDS_WAIT(); asm volatile("" ::: "memory");
    const int nl = lane >> 3, kc = lane & 7;
#pragma unroll
    for (int j = 0; j < 8; ++j) { const int n = nl + 8 * j; const LAS float* s = scr + (8 * kc) * 65 + n;
        u32x4 o; o.x = cvtpk(s[0 * 65], s[1 * 65]); o.y = cvtpk(s[2 * 65], s[3 * 65]); o.z = cvtpk(s[4 * 65], s[5 * 65]); o.w = cvtpk(s[6 * 65], s[7 * 65]);
        *(u32x4*)(WT + (size_t)(drow0 + n) * ldk + k0 + 8 * kc) = o; }
    LDS_WAIT(); asm volatile("" ::: "memory");
}
__device__ __forceinline__ void conv_job(const float* W, int K, int N, bf16* WT, const float* gain, bool gu, LAS float* scr, int gw, int NGW, int lane, int& base) {
    const bool wide = (N & 63) == 0; const int bn = wide ? 64 : 32;
    const int nnb = N / bn, nitems = (K / 64) * nnb;
    int first = (gw - (base % NGW) + NGW) % NGW;
    for (int it = first; it < nitems; it += NGW) { const int kb = it / nnb, nb = it % nnb, n0 = bn * nb;
        int drow0 = n0;
        if (gu) { const int j = n0 < DFF ? n0 : n0 - DFF; drow0 = (j >> 7) * 256 + (j & 127) + (n0 < DFF ? 0 : 128); }
        if (wide) tr_item64(W, N, WT, K, gain, scr, 64 * kb, n0, drow0, lane); else tr_item(W, N, WT, K, gain, scr, 64 * kb, n0, drow0, lane); }
    base += nitems;
}

namespace att {
constexpr int KROW = 208, VROW = 136, KBUF = 64 * KROW, VBUF = 64 * VROW, K_OFF = 0, V_OFF = 2 * KBUF, WS_OFF = V_OFF + 2 * VBUF;
#define MFMA32(a, b, c) __builtin_amdgcn_mfma_f32_32x32x16_bf16((a), (b), (c), 0, 0, 0)
__device__ __forceinline__ void unit(LAS unsigned char* lds, const bf16* __restrict__ Q, const bf16* __restrict__ KN, const bf16* __restrict__ KR, const bf16* __restrict__ VT, bf16* __restrict__ O,
                                     int qrow0, int kvbase, int NT, int tmax, int h) {
    const int tid = opaque_tid(), lane = tid & 63, r32 = lane & 31, hi = lane >> 5; const int wid = __builtin_amdgcn_readfirstlane(tid >> 6);
    const bool active = tmax >= 0;
    const int r0 = tid / 12, c0 = tid % 12, e1 = 512 + tid, r1 = e1 / 12, c1 = e1 % 12; const bool has1 = tid < 256;
    const bf16* s0 = c0 < 8 ? KN + (size_t)(kvbase + r0) * 1024 + h * 64 + c0 * 8 : KR + (size_t)(kvbase + r0) * 32 + (c0 - 8) * 8; const size_t st0 = c0 < 8 ? 64 * 1024 : 64 * 32;
    const bf16* s1 = c1 < 8 ? KN + (size_t)(kvbase + r1) * 1024 + h * 64 + c1 * 8 : KR + (size_t)(kvbase + r1) * 32 + (c1 - 8) * 8; const size_t st1 = c1 < 8 ? 64 * 1024 : 64 * 32;
    const int vd = tid >> 3, vc = tid & 7;
    const bf16* sv = VT + (size_t)(h * 64 + vd) * NKV + kvbase + vc * 8;
    const int kd0 = K_OFF + r0 * KROW + c0 * 16, kd1 = K_OFF + r1 * KROW + c1 * 16, vdst = V_OFF + vd * VROW + vc * 16;
    bf16x8 qr[6];
    const int qrow = qrow0 + 32 * (active ? wid : 0) + r32;
#pragma unroll
    for (int d0 = 0; d0 < 6; ++d0) qr[d0] = *(const bf16x8*)(Q + (size_t)qrow * 1536 + h * 96 + d0 * 16 + hi * 8);
    float mref = 0.f, lrun = 0.f; f32x16 o0 = {}, o1 = {}, negm = {};
    u32x4 k0v = *(const u32x4*)s0, k1v = has1 ? *(const u32x4*)s1 : (u32x4){0u, 0u, 0u, 0u}, vv = *(const u32x4*)sv;
    u32x4 k0w = k0v, k1w = k1v, vw = vv;
    if (NT > 1) { k0w = *(const u32x4*)(s0 + st0); if (has1) k1w = *(const u32x4*)(s1 + st1); vw = *(const u32x4*)(sv + 64); }
    *(LAS u32x4*)(lds + kd0) = k0v; if (has1) *(LAS u32x4*)(lds + kd1) = k1v; *(LAS u32x4*)(lds + vdst) = vv;
    k0v = k0w; k1v = k1w; vv = vw;
    __syncthreads();
    LAS float* wsf = (LAS float*)(lds + WS_OFF) + wid * 32;
    for (int t = 0; t < NT; ++t) {
        const int cur = t & 1; const bool more = t + 1 < NT;
        if (t + 2 < NT) { k0w = *(const u32x4*)(s0 + (size_t)(t + 2) * st0); if (has1) k1w = *(const u32x4*)(s1 + (size_t)(t + 2) * st1); vw = *(const u32x4*)(sv + (size_t)(t + 2) * 64); }
        if (t <= tmax) {
            const LAS unsigned char* Kb = lds + K_OFF + cur * KBUF + r32 * KROW + hi * 16; const LAS unsigned char* Vb = lds + V_OFF + cur * VBUF + r32 * VROW + hi * 8;
            bf16x8 kf[12];
#pragma unroll
            for (int d0 = 0; d0 < 6; ++d0) { kf[2 * d0] = *(const LAS bf16x8*)(Kb + d0 * 32); kf[2 * d0 + 1] = *(const LAS bf16x8*)(Kb + 32 * KROW + d0 * 32); }
            __builtin_amdgcn_sched_barrier(0);
            f32x16 p0 = MFMA32(kf[0], qr[0], negm), p1 = MFMA32(kf[1], qr[0], negm);
#pragma unroll
            for (int d0 = 1; d0 < 6; ++d0) { p0 = MFMA32(kf[2 * d0], qr[d0], p0); p1 = MFMA32(kf[2 * d0 + 1], qr[d0], p1); }
            s16x4 vl0[4], vh0[4], vl1[4], vh1[4];
#pragma unroll
            for (int ks = 0; ks < 4; ++ks) { vl0[ks] = *(const LAS s16x4*)(Vb + ks * 32); vh0[ks] = *(const LAS s16x4*)(Vb + ks * 32 + 16);
                vl1[ks] = *(const LAS s16x4*)(Vb + 32 * VROW + ks * 32); vh1[ks] = *(const LAS s16x4*)(Vb + 32 * VROW + ks * 32 + 16); }
            __builtin_amdgcn_sched_barrier(0);
            float ma = __builtin_fmaxf(__builtin_fmaxf(p0[0], p0[1]), p1[0]), mb = __builtin_fmaxf(__builtin_fmaxf(p0[2], p0[3]), p1[1]);
            ma = __builtin_fmaxf(__builtin_fmaxf(ma, p1[2]), p1[3]);
#pragma unroll
            for (int i = 4; i < 16; i += 4) { ma = __builtin_fmaxf(__builtin_fmaxf(ma, p0[i]), p0[i + 1]); mb = __builtin_fmaxf(__builtin_fmaxf(mb, p0[i + 2]), p0[i + 3]);
                ma = __builtin_fmaxf(__builtin_fmaxf(ma, p1[i]), p1[i + 1]); mb = __builtin_fmaxf(__builtin_fmaxf(mb, p1[i + 2]), p1[i + 3]); }
            float mx = __builtin_fmaxf(ma, mb); mx = __builtin_fmaxf(mx, __shfl_xor(mx, 32));
            if (t == 0 || __any(mx > 8.0f)) {
                const float dl = t == 0 ? mx : __builtin_fmaxf(mx, 0.f); mref += dl;
#pragma unroll
                for (int i = 0; i < 16; ++i) { p0[i] -= dl; p1[i] -= dl; negm[i] = -mref; }
                if (t != 0) { const float fsc = __builtin_amdgcn_exp2f(-dl); lrun *= fsc;
                    if (hi == 0) wsf[r32] = fsc;
#pragma unroll
                    for (int g = 0; g < 4; ++g) { const f32x4 a = *(const LAS f32x4*)(wsf + 8 * g + 4 * hi);
#pragma unroll
                        for (int j = 0; j < 4; ++j) { o0[4 * g + j] *= a[j]; o1[4 * g + j] *= a[j]; } } }
            }
            typedef float f32x2v __attribute__((ext_vector_type(2)));
            f32x2v rs2 = {0.f, 0.f};
#pragma unroll
            for (int i = 0; i < 16; ++i) { p0[i] = __builtin_amdgcn_exp2f(p0[i]); p1[i] = __builtin_amdgcn_exp2f(p1[i]); }
#pragma unroll
            for (int i = 0; i < 16; i += 2) { rs2 += (f32x2v){p0[i], p0[i + 1]}; rs2 += (f32x2v){p1[i], p1[i + 1]}; }
            lrun += rs2.x + rs2.y;
            bf16x8 pa[4];
#pragma unroll
            for (int s = 0; s < 2; ++s) { u32x4 w0, w1;
                w0.x = cvtpk(p0[8 * s + 0], p0[8 * s + 1]); w0.y = cvtpk(p0[8 * s + 2], p0[8 * s + 3]); w0.z = cvtpk(p0[8 * s + 4], p0[8 * s + 5]); w0.w = cvtpk(p0[8 * s + 6], p0[8 * s + 7]);
                w1.x = cvtpk(p1[8 * s + 0], p1[8 * s + 1]); w1.y = cvtpk(p1[8 * s + 2], p1[8 * s + 3]); w1.z = cvtpk(p1[8 * s + 4], p1[8 * s + 5]); w1.w = cvtpk(p1[8 * s + 6], p1[8 * s + 7]);
                pa[s] = __builtin_bit_cast(bf16x8, w0); pa[2 + s] = __builtin_bit_cast(bf16x8, w1); }
#pragma unroll
            for (int ks = 0; ks < 4; ++ks) {
                const s16x4 l0 = vl0[ks], h0 = vh0[ks], l1 = vl1[ks], h1 = vh1[ks];
                const bf16x8 v0 = {l0[0], l0[1], l0[2], l0[3], h0[0], h0[1], h0[2], h0[3]}, v1 = {l1[0], l1[1], l1[2], l1[3], h1[0], h1[1], h1[2], h1[3]};
                o0 = MFMA32(pa[ks], v0, o0); o1 = MFMA32(pa[ks], v1, o1); }
        }
        if (more) { const int nb = cur ^ 1; *(LAS u32x4*)(lds + kd0 + nb * KBUF) = k0v; if (has1) *(LAS u32x4*)(lds + kd1 + nb * KBUF) = k1v; *(LAS u32x4*)(lds + vdst + nb * VBUF) = vv; }
        k0v = k0w; k1v = k1w; vv = vw;
        __syncthreads();
    }
    if (active) {
        lrun += __shfl_xor(lrun, 32);
        if (hi == 0) wsf[r32] = 1.f / lrun;
        bf16* Ow = O + (size_t)(qrow0 + 32 * wid) * 1024 + h * 64 + r32;
#pragma unroll
        for (int g = 0; g < 4; ++g) { const f32x4 inv = *(const LAS f32x4*)(wsf + 8 * g + 4 * hi);
#pragma unroll
            for (int j = 0; j < 4; ++j) { const int row = 8 * g + 4 * hi + j; const unsigned w = cvtpk(o0[4 * g + j] * inv[j], o1[4 * g + j] * inv[j]);
                Ow[(size_t)row * 1024] = (bf16)(w & 0xffffu); Ow[(size_t)row * 1024 + 32] = (bf16)(w >> 16); } }
    }
}
__device__ __forceinline__ void phase(LAS unsigned char* lds, const bf16* Q, const bf16* KN, const bf16* KR, const bf16* VT, bf16* O, int vcu, int G) {
    const int wid = __builtin_amdgcn_readfirstlane((int)threadIdx.x >> 6);
    for (int p = vcu; p < 1024 + 128; p += G) {
        const int nsub = p < 1024 ? 2 : 1;
        for (int sub = 0; sub < nsub; ++sub) {
            int qrow0, kvbase, NT, tmax, h;
            if (p < 1024) { const int bh = p >> 4, pp = p & 15, b = bh >> 4, qb = sub ? pp : 31 - pp; h = bh & 15; qrow0 = b * SEQ + qb * 256; kvbase = b * SEQ; NT = 4 * qb + 4; tmax = 4 * qb + (wid >> 1); }
            else { const int su = p - 1024, sb = su >> 4; h = su & 15; qrow0 = MP + sb * 64; kvbase = MP + sb * KVS; NT = KVS / 64; tmax = wid < 2 ? NT - 1 : -1; }
            unit(lds, Q, KN, KR, VT, O, qrow0, kvbase, NT, tmax, h);
        }
    }
}
}

namespace sg {
constexpr int VTROW = 272;
__device__ __forceinline__ void phase(LAS unsigned char* lds, const bf16* Z, bf16* P, const float* ssv, const float* vgain  , const bf16* Wm  , const float* bsg  ,
                                      float* av_out  , int vcu, int G) {
    const int tid = opaque_tid(), lane = tid & 63, fr = lane & 15, fq = lane >> 4; const int wid = __builtin_amdgcn_readfirstlane(tid >> 6);
    for (int un = vcu; un < (MT / 128) * 8; un += G) {
        const int blk = un >> 3, g = un & 7, r0 = blk * 128; const int typ = blk >= MP / 128 ? 1 : 0;
#pragma unroll
        for (int i = 0; i < 4; ++i) { const int e = tid + 512 * i, s = e >> 4, c8 = e & 15; const int row = r0 + s;
            const int ssw = s ^ (8 * c8);
            const u32x4 raw = *(const u32x4*)(Z + (size_t)row * 2048 + 1024 + g * 128 + c8 * 8);
            const float r = __builtin_amdgcn_rsqf(pg8::ld_stat(ssv + row) * (1.f / 1024.f) + EPS);
            const f32x4 g0 = *(const f32x4*)(vgain + g * 128 + c8 * 8), g1 = *(const f32x4*)(vgain + g * 128 + c8 * 8 + 4);
            float v[8];
#pragma unroll
            for (int j = 0; j < 4; ++j) { const unsigned w = raw[j]; v[2 * j] = __uint_as_float(w << 16); v[2 * j + 1] = __uint_as_float(w & 0xffff0000u); }
#pragma unroll
            for (int j = 0; j < 4; ++j) { v[j] *= r * g0[j]; v[4 + j] *= r * g1[j]; }
            if (typ) { float* ap = av_out + (size_t)(row - MP) * 1024 + g * 128 + c8 * 8; *(f32x4*)ap = (f32x4){v[0], v[1], v[2], v[3]}; *(f32x4*)(ap + 4) = (f32x4){v[4], v[5], v[6], v[7]}; }
#pragma unroll
            for (int j = 0; j < 4; ++j) { const unsigned w = cvtpk(v[2 * j], v[2 * j + 1]);
                *(LAS bf16*)(lds + (c8 * 8 + 2 * j) * VTROW + ssw * 2) = (bf16)(w & 0xffffu); *(LAS bf16*)(lds + (c8 * 8 + 2 * j + 1) * VTROW + ssw * 2) = (bf16)(w >> 16); }
        }
        __syncthreads();
        const bf16* W = Wm + ((size_t)(typ * 8 + g) * 128 + 16 * wid + fr) * 128 + 8 * fq;
        f32x4 acc[8];
#pragma unroll
        for (int n = 0; n < 8; ++n) acc[n] = (f32x4){0.f, 0.f, 0.f, 0.f};
#pragma unroll
        for (int k = 0; k < 4; ++k) {
            if (32 * k <= 16 * wid + 15) {
                const bf16x8 wf = *(const bf16x8*)(W + 32 * k);
#pragma unroll
                for (int n = 0; n < 8; ++n) { const bf16x8 vf = *(const LAS bf16x8*)(lds + (16 * n + fr) * VTROW + ((32 * k + 8 * fq) ^ (8 * (2 * n + (fr >> 3)))) * 2);
                    acc[n] = __builtin_amdgcn_mfma_f32_16x16x32_bf16(vf, wf, acc[n], 0, 0, 0); }
            }
        }
        const int t = 16 * wid + fr, row = r0 + t; const float bias = bsg[(typ * 8 + g) * 128 + t];
#pragma unroll
        for (int n = 0; n < 8; ++n) { const size_t col = (size_t)g * 128 + 16 * n + 4 * fq;
            const u32x2 ur = *(const u32x2*)(Z + (size_t)row * 2048 + col);
            const float u0 = __uint_as_float(ur.x << 16), u1 = __uint_as_float(ur.x & 0xffff0000u), u2 = __uint_as_float(ur.y << 16), u3 = __uint_as_float(ur.y & 0xffff0000u);
            u32x2 w; w.x = cvtpk(u0 * (acc[n][0] + bias), u1 * (acc[n][1] + bias)); w.y = cvtpk(u2 * (acc[n][2] + bias), u3 * (acc[n][3] + bias));
            *(u32x2*)(P + (size_t)row * 1024 + col) = w; }
        __syncthreads();
    }
}
}

typedef GAS unsigned gu32;
#define XB_TMO      128
#define XB_XCNT(j)  (256  + 64 * (j))
#define XB_XSUB(j)  (1280 + 64 * (j))
#define XB_XGEN(j)  (2304 + 64 * (j))
#define XB_TOP      3328
#define XB_TOPGEN   3392
#define XCD_BAR_WORDS 3456
#define XB_SPIN_CAP (1u << 18)

__device__ __forceinline__ unsigned xb_ld(unsigned* p)              { return __hip_atomic_load(p, __ATOMIC_RELAXED, __HIP_MEMORY_SCOPE_AGENT); }
__device__ __forceinline__ unsigned xb_add(unsigned* p, unsigned v) { return __hip_atomic_fetch_add(p, v, __ATOMIC_RELAXED, __HIP_MEMORY_SCOPE_AGENT); }
__device__ __forceinline__ unsigned xb_xcc_id() { return (unsigned)__builtin_amdgcn_s_getreg((3 << 11) | 20) & 0xFu; }
#define XB_SPIN(cond, bar) do { unsigned _sp = 0; while (cond) { __builtin_amdgcn_s_sleep(1); \
    if ((++_sp & 255u) == 0u) { if (xb_ld(&(bar)[XB_TMO])) break; if (_sp > XB_SPIN_CAP) { atomicAdd(&(bar)[XB_TMO], 1u); break; } } } } while (0)

struct XcdBarrier {
    unsigned* bar; unsigned x;
    volatile LAS unsigned* st;
};

__device__ __forceinline__ XcdBarrier xcd_barrier_post(unsigned* bar, volatile LAS unsigned* st) {
    XcdBarrier b; b.bar = bar; b.x = xb_xcc_id(); b.st = st;
    if (threadIdx.x == 0) (void)xb_add(&bar[XB_XCNT(b.x)], 1u);
    return b;
}
__device__ __forceinline__ void xcd_barrier_complete(unsigned* bar, unsigned x, unsigned& nloc, unsigned& nx) {
    const unsigned G = gridDim.x * gridDim.y * gridDim.z;
    unsigned sum, cnt, mine, sp = 0u;
    for (;;) {
        sum = 0u; cnt = 0u; mine = 0u;
#pragma unroll
        for (unsigned j = 0; j < 16; ++j) { const unsigned c = xb_ld(&bar[XB_XCNT(j)]); sum += c; cnt += (c > 0u) ? 1u : 0u; mine = (j == x) ? c : mine; }
        if (sum == G) break;
        __builtin_amdgcn_s_sleep(1);
        if ((++sp & 255u) == 0u) { if (xb_ld(&bar[XB_TMO])) break; if (sp > XB_SPIN_CAP) { atomicAdd(&bar[XB_TMO], 1u); break; } }
    }
    nloc = mine > 0u ? mine : 1u; nx = cnt > 0u ? cnt : 1u;
}

__device__ __forceinline__ void xcd_barrier(const XcdBarrier& b) {
    asm volatile("s_waitcnt vmcnt(0)" ::: "memory");
    __syncthreads();
    if (threadIdx.x == 0) {
        unsigned* bar = b.bar;
        __builtin_amdgcn_s_waitcnt(0);
        unsigned nloc = b.st[0], nx = b.st[1];
        if (nloc == 0u) { xcd_barrier_complete(bar, b.x, nloc, nx); b.st[0] = nloc; b.st[1] = nx; }
        const unsigned old = xb_add(&bar[XB_XSUB(b.x)], 1u);
        const unsigned gen = old / nloc;
        if (old + 1u == (gen + 1u) * nloc) {
            __builtin_amdgcn_fence(__ATOMIC_RELEASE, "agent");
            asm volatile("s_waitcnt vmcnt(0)" ::: "memory");
            const unsigned og = xb_add(&bar[XB_TOP], 1u);
            const unsigned tg = og / nx;
            if (og + 1u == (tg + 1u) * nx) xb_add(&bar[XB_TOPGEN], 1u);
            else XB_SPIN(xb_ld(&bar[XB_TOPGEN]) == tg, bar);
            __builtin_amdgcn_fence(__ATOMIC_ACQUIRE, "agent");
            xb_add(&bar[XB_XGEN(b.x)], 1u);
            asm volatile("s_waitcnt vmcnt(0)" ::: "memory");
        } else {
            XB_SPIN(xb_ld(&bar[XB_XGEN(b.x)]) == gen, bar);
            __builtin_amdgcn_fence(__ATOMIC_ACQUIRE, "agent");
            asm volatile("s_waitcnt vmcnt(0)" ::: "memory");
        }
    }
    __syncthreads();
}

__device__ __forceinline__ void subset_sync(unsigned* cnt, unsigned target, bool wait) {
    asm volatile("s_waitcnt vmcnt(0)" ::: "memory");
    __syncthreads();
    if (threadIdx.x == 0) {
        __builtin_amdgcn_fence(__ATOMIC_RELEASE, "agent");
        asm volatile("s_waitcnt vmcnt(0)" ::: "memory");
        (void)__hip_atomic_fetch_add(cnt, 1u, __ATOMIC_RELAXED, __HIP_MEMORY_SCOPE_AGENT);
        if (wait) { unsigned sp = 0;
            while (__hip_atomic_load(cnt, __ATOMIC_RELAXED, __HIP_MEMORY_SCOPE_AGENT) < target) { __builtin_amdgcn_s_sleep(2); if (++sp > (1u << 22)) break; }
            __builtin_amdgcn_fence(__ATOMIC_ACQUIRE, "agent");
            asm volatile("s_waitcnt vmcnt(0)" ::: "memory"); }
    }
    __syncthreads();
}
__global__ void __launch_bounds__(NWAVES * 64, 2) mk_fwd(Args args) {
    extern __shared__ __attribute__((aligned(16))) unsigned char lds_raw[];
    LAS unsigned char* lds = (LAS unsigned char*)lds_raw;
    cg::grid_group grid = cg::this_grid();
#define wave (__builtin_amdgcn_readfirstlane((int)threadIdx.x >> 6))
#define TIDLANE() const int tid = opaque_tid(), lane = tid & 63; (void)tid; (void)lane
#define G ((int)gridDim.x)
#define bx ((int)blockIdx.x)
#define vcu ((G % 8 == 0) ? (bx % 8) * (G / 8) + bx / 8 : bx)
#define gw (vcu * NWAVES + wave)
#define NGW (G * NWAVES)
#define ARGP() const __attribute__((address_space(4))) Args* ap = (const __attribute__((address_space(4))) Args*)__builtin_amdgcn_kernarg_segment_ptr(); asm volatile("" : "+s"(ap))
#define IN(i) (ap->in[(i)])
#define OUTP (ap->out)
#define WS (ap->ws)
#define stats ((float*)(WS + WS_STATS))
#define SH(k) (stats + (size_t)(k) * MT)
#define SV(l) (stats + (size_t)(13 + (l)) * MT)
#define SQ(j) (stats + (size_t)(15 + (j)) * MT)
#define SC() (stats + (size_t)17 * MT)
#define HRES (OUTP + OUT_Y)
#define hb ((bf16*)(WS + WS_HB))
#define scr (WS + WS_SCR)
#define HID ((bf16*)scr)
#define Zb ((bf16*)scr)
#define Pb ((bf16*)(WS + WS_KN))
#define KVRAW ((float*)scr)
#define CKVALL ((bf16*)(scr + SCR_CKVALL))
#define Qb ((bf16*)scr)
#define Ob ((bf16*)(scr + SCR_O))
#define QLb ((bf16*)(scr + SCR_QL))
#define KNb ((bf16*)(WS + WS_KN))
#define VTb ((bf16*)(WS + WS_VT))
#define KRb ((bf16*)(WS + WS_KR))
#define rope ((const float*)(WS + WS_ROPE))
#define cscr ((LAS float*)(lds + wave * 16640))
#define RUN true
    if (threadIdx.x < 2) ((volatile LAS unsigned*)(lds + XB_LDS_OFF))[threadIdx.x] = 0u;
    __syncthreads();
    XcdBarrier xbar = xcd_barrier_post((unsigned*)(args.ws + WS_BAR), (volatile LAS unsigned*)(lds + XB_LDS_OFF));
#define SEAM() xcd_barrier(xbar)

    for (int rep = 0; rep < REP_PRO; ++rep) { ARGP(); TIDLANE(); if (rep) grid.sync();
        for (size_t i = (size_t)MT + (size_t)bx * 512 + tid; i < (size_t)18 * MT; i += (size_t)G * 512) stats[i] = 0.f;
        for (int m = gw; m < MT; m += NGW) { const float* xr = m < MP ? IN(I_XP) + (size_t)m * DM : IN(I_XS) + (size_t)(m - MP) * DM;
            float s = 0.f;
#pragma unroll
            for (int j = 0; j < 4; ++j) { const f32x4 v = *(const f32x4*)(xr + 256 * j + 4 * lane); if (G != 256) *(f32x4*)(HRES + (size_t)m * DM + 256 * j + 4 * lane) = v;
                u32x2 w; w.x = cvtpk(v[0], v[1]); w.y = cvtpk(v[2], v[3]); *(u32x2*)(hb + (size_t)m * DM + 256 * j + 4 * lane) = w;
                s += (v[0] * v[0] + v[1] * v[1]) + (v[2] * v[2] + v[3] * v[3]); }
            s = wave_sum(s); if (lane == 0) SH(0)[m] = s; }
        for (int i = bx * 512 + tid; i < SEQ * 16; i += G * 512) { const int pos = i >> 4, k = i & 15; const float inv = 1.0f / powf(10000.0f, (float)k * (2.0f / 32.0f)); const float ang = (float)pos * inv;
            ((float*)(WS + WS_ROPE))[pos * 32 + k] = cosf(ang); ((float*)(WS + WS_ROPE))[pos * 32 + 16 + k] = sinf(ang); }
        for (int i = bx * 512 + tid; i < 2 * 2 * 8 * 128 * 128; i += G * 512) { const int s = i & 127, t = (i >> 7) & 127, g = (i >> 14) & 7, typ = (i >> 17) & 1, l = i >> 18;
            float w = 0.f;
            if (typ == 0) { if (s <= t) w = IN(I_AWS)[(((size_t)l * 8 + g) * 128 + t) * 128 + s]; }
            else { if ((s >> 6) == (t >> 6) && (s & 63) <= (t & 63)) w = IN(I_AWS)[(((size_t)l * 8 + g) * 128 + (t & 63)) * 128 + (s & 63)]; }
            ((bf16*)(WS + WS_WM))[i] = (bf16)(cvtpk(w, 0.f) & 0xffffu); }
        for (int i = bx * 512 + tid; i < 2 * 2 * 8 * 128; i += G * 512) { const int t = i & 127, g = (i >> 7) & 7, typ = (i >> 10) & 1, l = i >> 11;
            ((float*)(WS + WS_BSG))[i] = IN(I_ABS)[((size_t)l * 8 + g) * 128 + (typ ? (t & 63) : t)]; }
        for (int i = bx * 512 + tid; i < 96 * 1024 / 8; i += G * 512) ((u32x4*)(WS + WS_WDKV + (size_t)160 * 1024 * 2))[i] = (u32x4){0u, 0u, 0u, 0u};
        int base = 0;
        for (int l = 0; l < 2; ++l) {
            conv_job(IN(I_AWIN) + (size_t)l * 1024 * 2048, 1024, 2048, (bf16*)(WS + WS_WIN + (size_t)l * 4 * MiB), IN(I_MIXN) + l * 1024, false, cscr, gw, NGW, lane, base);
            conv_job(IN(I_AWOUT) + (size_t)l * 1024 * 1024, 1024, 1024, (bf16*)(WS + WS_WOUT + (size_t)l * 2 * MiB), nullptr, false, cscr, gw, NGW, lane, base);
            conv_job(IN(I_BWDQ) + (size_t)l * 1024 * 256, 1024, 256, (bf16*)(WS + WS_WDQ + (size_t)l * 512 * KiB), IN(I_MIXN) + (2 + l) * 1024, false, cscr, gw, NGW, lane, base);
            conv_job(IN(I_BWUQ) + (size_t)l * 256 * 1536, 256, 1536, (bf16*)(WS + WS_WUQ + (size_t)l * 768 * KiB), IN(I_BQN) + l * 256, false, cscr, gw, NGW, lane, base);
            conv_job(IN(I_BWO) + (size_t)l * 1024 * 1024, 1024, 1024, (bf16*)(WS + WS_WO + (size_t)l * 2 * MiB), nullptr, false, cscr, gw, NGW, lane, base);
        }
        conv_job(IN(I_WDKV), 1024, 160, (bf16*)(WS + WS_WDKV), IN(I_KVN), false, cscr, gw, NGW, lane, base);
        conv_job(IN(I_WUK), 128, 1024, (bf16*)(WS + WS_WUK), nullptr, false, cscr, gw, NGW, lane, base);
        conv_job(IN(I_WUV), 128, 1024, (bf16*)(WS + WS_WUV), nullptr, false, cscr, gw, NGW, lane, base);
    }

    for (int l = 0; l < 4; ++l) {
        if (G != 256 || l == 0) { ARGP(); TIDLANE(); int base = 0;
            conv_job(IN(I_F1GU) + (size_t)l * 1024 * 5632, 1024, 5632, (bf16*)(WS + WS_WGU1), IN(I_F1N) + l * 1024, true, cscr, gw, NGW, lane, base);
            conv_job(IN(I_F1D) + (size_t)l * 2816 * 1024, 2816, 1024, (bf16*)(WS + WS_WD1), nullptr, false, cscr, gw, NGW, lane, base);
            if (G != 256) {
            conv_job(IN(I_F2GU) + (size_t)l * 1024 * 5632, 1024, 5632, (bf16*)(WS + WS_WGU2), IN(I_F2N) + l * 1024, true, cscr, gw, NGW, lane, base);
            conv_job(IN(I_F2D) + (size_t)l * 2816 * 1024, 2816, 1024, (bf16*)(WS + WS_WD2), nullptr, false, cscr, gw, NGW, lane, base); }
            __syncthreads(); }
        if (args.ws == nullptr) grid.sync();
        if (l == 0 || G != 256) SEAM();
#if REP_CONV > 1
        if (RUN) { ARGP(); TIDLANE(); int base = 0;
            conv_job(IN(I_F1GU) + (size_t)l * 1024 * 5632, 1024, 5632, (bf16*)(WS + WS_WGU1), IN(I_F1N) + l * 1024, true, cscr, gw, NGW, lane, base);
            conv_job(IN(I_F1D) + (size_t)l * 2816 * 1024, 2816, 1024, (bf16*)(WS + WS_WD1), nullptr, false, cscr, gw, NGW, lane, base);
            conv_job(IN(I_F2GU) + (size_t)l * 1024 * 5632, 1024, 5632, (bf16*)(WS + WS_WGU2), IN(I_F2N) + l * 1024, true, cscr, gw, NGW, lane, base);
            conv_job(IN(I_F2D) + (size_t)l * 2816 * 1024, 2816, 1024, (bf16*)(WS + WS_WD2), nullptr, false, cscr, gw, NGW, lane, base);
            __syncthreads(); }
        SEAM();
#endif
        for (int step = 0; step < 3; ++step) { const int hv = 3 * l + step;
            size_t rA, rB; int rK; float ralpha;
            if (step != 1) {
                if (G == 256) {
                    for (int pass = 0; pass < 2; ++pass) {
                        if (pass == 1 && bx < 44) { ARGP();
                            subset_sync((unsigned*)(WS + WS_SUB) + 64 * (2 * l + (step >> 1)), 44u, bx < 8);
                            pg8::Gemm g{HID, (const bf16*)(WS + (step == 0 ? WS_WD1 : WS_WD2)), MT, DM, DFF}; pg8::FfnOrder S; S.so.init(MP, DM, G, bx); S.mode = 1;
                            pg8::EpiRes E{hv == 0 ? IN(I_XS) - (size_t)MP * DM : (const float*)HRES, HRES, hb, SH(hv + 1), 0.5f};
                            pg8::gemm_phase<pg8::EpiRes, pg8::FfnOrder, false, true>(lds, g, S, E); }
                        { ARGP(); pg8::Gemm g{hb, (const bf16*)(WS + (step == 0 ? WS_WGU1 : WS_WGU2)), MT, 2 * DFF, DM}; pg8::FfnOrder S; S.so.init(MP, 2 * DFF, G, bx); S.mode = pass ? 2 : 0;
                            pg8::EpiGU E{HID, SH(hv)};
                            pg8::gemm_phase<pg8::EpiGU, pg8::FfnOrder, true, true>(lds, g, S, E); }
                    }
                    if (bx >= 84 && (step == 0 || l < 3)) { ARGP(); TIDLANE(); int base = 0; const int cgw = (bx - 84) * NWAVES + wave, cng = (256 - 84) * NWAVES; const int cl = step == 0 ? l : l + 1;
                        conv_job(IN(step == 0 ? I_F2GU : I_F1GU) + (size_t)cl * 1024 * 5632, 1024, 5632, (bf16*)(WS + (step == 0 ? WS_WGU2 : WS_WGU1)), IN(step == 0 ? I_F2N : I_F1N) + cl * 1024, true, cscr, cgw, cng, lane, base);
                        conv_job(IN(step == 0 ? I_F2D : I_F1D) + (size_t)cl * 2816 * 1024, 2816, 1024, (bf16*)(WS + (step == 0 ? WS_WD2 : WS_WD1)), nullptr, false, cscr, cgw, cng, lane, base);
                        __syncthreads(); }
                } else {
                    ARGP(); pg8::Gemm g{hb, (const bf16*)(WS + (step == 0 ? WS_WGU1 : WS_WGU2)), MT, 2 * DFF, DM}; pg8::StaticOrder S; S.init(MT, 2 * DFF, G, bx);
                    pg8::EpiGU E{HID, SH(hv)};
                    pg8::gemm_phase<pg8::EpiGU, pg8::StaticOrder, true, true>(lds, g, S, E); }
                SEAM();
#if REP_GU > 1
                if (RUN) { ARGP(); pg8::Gemm g{hb, (const bf16*)(WS + (step == 0 ? WS_WGU1 : WS_WGU2)), MT, 2 * DFF, DM}; pg8::StaticOrder S; S.init(MT, 2 * DFF, G, bx);
                    pg8::EpiGU E{HID, SH(hv)};
                    pg8::gemm_phase<pg8::EpiGU, pg8::StaticOrder, true, true>(lds, g, S, E); }
                SEAM();
#endif
                rA = WS_SCR; rB = step == 0 ? WS_WD1 : WS_WD2; rK = DFF; ralpha = 0.5f;
            } else if (l < 2) {
                if (RUN) { ARGP(); pg8::Gemm g{hb, (const bf16*)(WS + WS_WIN + (size_t)l * 4 * MiB), MT, 2048, DM}; pg8::StaticOrder S; S.init(MT, 2048, G, bx);
                    pg8::EpiWin E{Zb, SH(hv), SV(l)};
                    pg8::gemm_phase<pg8::EpiWin, pg8::StaticOrder, true, true>(lds, g, S, E); }
                SEAM();
#ifndef NO_SG
                for (int rep = 0; rep < REP_OTH; ++rep) { if (rep) SEAM(); ARGP(); sg::phase(lds, Zb, Pb, SV(l), IN(I_AVN) + l * 1024, (const bf16*)(WS + WS_WM) + (size_t)l * 2 * 8 * 128 * 128, (const float*)(WS + WS_BSG) + l * 2 * 8 * 128,
                                   OUTP + OUT_AV + (size_t)l * MS * 1024, vcu, G); }
#endif
                SEAM();
                rA = WS_KN; rB = WS_WOUT + (size_t)l * 2 * MiB; rK = DM; ralpha = 1.f;
            } else {
                const int j = l - 2;
                if (RUN) { ARGP(); pg8::Gemm g{hb, (const bf16*)(WS + WS_WDQ + (size_t)j * 512 * KiB), MT, 256, DM}; pg8::StaticOrder S; S.init(MT, 256, G, bx);
                    pg8::EpiQL E{QLb, SH(hv), SQ(j)};
                    pg8::gemm_phase<pg8::EpiQL, pg8::StaticOrder, true, true>(lds, g, S, E); }
                SEAM();
                for (int rep = 0; rep < REP_OTH; ++rep) { if (rep) SEAM(); ARGP(); int kq = 256; asm volatile("" : "+s"(kq));
                    pg8::Gemm g{QLb, (const bf16*)(WS + WS_WUQ + (size_t)j * 768 * KiB), MT, 1536, kq}; pg8::StaticOrder S; S.init(MT, 1536, G, bx);
                    pg8::EpiQ E{Qb, SQ(j), rope, QSCALE};
                    pg8::gemm_phase<pg8::EpiQ, pg8::StaticOrder, true, true>(lds, g, S, E); }
                SEAM();
#ifndef NO_ATT
                if (RUN) { ARGP(); att::phase(lds, Qb, KNb, KRb, VTb, Ob, vcu, G); }
#if REP_ATT > 1
                SEAM();
                if (RUN) { ARGP(); att::phase(lds, Qb, KNb, KRb, VTb, Ob, vcu, G); }
#endif
#endif
                SEAM();
                rA = WS_SCR + SCR_O; rB = WS_WO + (size_t)j * 2 * MiB; rK = DM; ralpha = 1.f;
            }
            if (RUN) { ARGP(); pg8::Gemm g{(const bf16*)(WS + rA), (const bf16*)(WS + rB), MT, DM, rK}; pg8::StaticOrder S; S.init((step != 1 && G == 256) ? MP : MT, DM, G, bx);
                pg8::EpiRes E{(hv == 0 && G == 256) ? IN(I_XP) : (const float*)HRES, HRES, hb, SH(hv + 1), ralpha};
                pg8::gemm_phase<pg8::EpiRes, pg8::StaticOrder, true, true>(lds, g, S, E); }
            SEAM();
#if REP_RES > 1
            if (RUN) { ARGP(); pg8::Gemm g{(const bf16*)(WS + rA), (const bf16*)(WS + rB), MT, DM, rK}; pg8::StaticOrder S; S.init(MT, DM, G, bx);
                pg8::EpiRes E{HRES, HRES, hb, nullptr, 0.f};
                pg8::gemm_phase<pg8::EpiRes, pg8::StaticOrder, true, true>(lds, g, S, E); }
            SEAM();
#endif
        }
        if (l == 1) { const int hv = 6;
            if (RUN) { ARGP(); pg8::Gemm g{hb, (const bf16*)(WS + WS_WDKV), MT, 256, DM}; pg8::StaticOrder S; S.init(MT, 256, G, bx);
                pg8::EpiLat E{KVRAW, SH(hv), SC()};
                pg8::gemm_phase<pg8::EpiLat, pg8::StaticOrder, true, true>(lds, g, S, E); }
            SEAM();
            for (int rep = 0; rep < REP_OTH; ++rep) { if (rep) SEAM(); ARGP(); TIDLANE();
                for (int m = gw; m < MT; m += NGW) {
                    const bool smp = m >= MP; const int ms = m - MP; const int pos = smp ? PAST + (ms & 63) : (m & (SEQ - 1));
                    const size_t kvrow = smp ? (size_t)MP + (size_t)(ms >> 6) * KVS + PAST + (ms & 63) : (size_t)m;
                    const float* kv = KVRAW + (size_t)m * 160; const float r = __builtin_amdgcn_rsqf(pg8::ld_stat(SC() + m) * (1.f / 128.f) + EPS);
                    const float c0 = kv[2 * lane] * r * IN(I_CKVN)[2 * lane], c1 = kv[2 * lane + 1] * r * IN(I_CKVN)[2 * lane + 1];
                    float* co = smp ? OUTP + OUT_CKVS + (size_t)ms * 128 : OUTP + OUT_CKVP + (size_t)m * 128;
                    co[2 * lane] = c0; co[2 * lane + 1] = c1;
                    ((unsigned*)(CKVALL + kvrow * 128))[lane] = cvtpk(c0, c1);
                    if (lane < 16) { const float x1 = kv[128 + lane], x2 = kv[144 + lane], c = rope[pos * 32 + lane], s = rope[pos * 32 + 16 + lane];
                        const float o1 = x1 * c - x2 * s, o2 = x2 * c + x1 * s;
                        float* ko = smp ? OUTP + OUT_KRS + (size_t)ms * 32 : OUTP + OUT_KRP + (size_t)m * 32;
                        ko[lane] = o1; ko[16 + lane] = o2;
                        const unsigned w = cvtpk(o1, o2); KRb[kvrow * 32 + lane] = (bf16)(w & 0xffffu); KRb[kvrow * 32 + 16 + lane] = (bf16)(w >> 16); }
                }
                for (int m = gw; m < 8 * PAST; m += NGW) { const int b = m / PAST, t = m % PAST; const size_t kvrow = (size_t)MP + (size_t)b * KVS + t;
                    const float* cc = IN(I_CCKV) + (size_t)m * 128; ((unsigned*)(CKVALL + kvrow * 128))[lane] = cvtpk(cc[2 * lane], cc[2 * lane + 1]);
                    if (lane < 16) { const float* ck = IN(I_CKR) + (size_t)m * 32; ((unsigned*)(KRb + kvrow * 32))[lane] = cvtpk(ck[2 * lane], ck[2 * lane + 1]); } }
            }
            SEAM();
            for (int rep = 0; rep < REP_OTH; ++rep) { if (rep) SEAM(); ARGP();
                { int kq = 128; asm volatile("" : "+s"(kq)); pg8::Gemm g{CKVALL, (const bf16*)(WS + WS_WUK), NKV, 1024, kq}; pg8::StaticOrder S; S.init(NKV, 1024, G, bx);
                  pg8::EpiPlain<1024> E{KNb};
                  pg8::gemm_phase<pg8::EpiPlain<1024>, pg8::StaticOrder, false, true>(lds, g, S, E); }
            }
            { ARGP();
                { int kq = 128; asm volatile("" : "+s"(kq)); pg8::Gemm g{(const bf16*)(WS + WS_WUV), CKVALL, 1024, NKV, kq}; pg8::StaticOrder S; S.init(1024, NKV, G, bx);
                  pg8::EpiPlain<NKV> E{VTb};
                  pg8::gemm_phase<pg8::EpiPlain<NKV>, pg8::StaticOrder, false, true>(lds, g, S, E); }
            }
            SEAM();
        }
    }
    if (RUN) { ARGP(); TIDLANE();
        for (int m = gw; m < MT; m += NGW) { const float r = __builtin_amdgcn_rsqf(pg8::ld_stat(SH(12) + m) * (1.f / 1024.f) + EPS);
#pragma unroll
            for (int j = 0; j < 4; ++j) { float* p = HRES + (size_t)m * DM + 256 * j + 4 * lane; const f32x4 v = *(const f32x4*)p, gn = *(const f32x4*)(IN(I_FN) + 256 * j + 4 * lane); *(f32x4*)p = v * r * gn; } }
    }
}

#undef G
#undef bx
#undef vcu
#undef gw
#undef NGW
#undef wave
#undef cscr
#undef stats
#undef scr
#undef rope
#undef hb
#undef IN
extern "C" void kernel_launch(void* const* d_in, const int* in_sizes, int n_in, void* d_out, int out_size, void* d_ws, size_t ws_size, hipStream_t stream) {
    static int grid = 0;
    if (grid == 0) {
        if (n_in != 26 || (size_t)out_size != OUT_END || ws_size < WS_END) { fprintf(stderr, "kernel_launch: unexpected shapes (n_in %d out %d ws %zu)\n", n_in, out_size, ws_size); grid = -1; return; }
        int dev = 0, cus = 0, per_cu = 0;
        hipGetDevice(&dev); hipDeviceGetAttribute(&cus, hipDeviceAttributeMultiprocessorCount, dev);
        if (hipFuncSetAttribute((const void*)mk_fwd, hipFuncAttributeMaxDynamicSharedMemorySize, LDS_BYTES) != hipSuccess) { fprintf(stderr, "kernel_launch: hipFuncSetAttribute failed\n"); grid = -1; return; }
        if (hipOccupancyMaxActiveBlocksPerMultiprocessor(&per_cu, (const void*)mk_fwd, NWAVES * 64, LDS_BYTES) != hipSuccess || per_cu < 1) { fprintf(stderr, "kernel_launch: occupancy query failed (%d)\n", per_cu); per_cu = 1; }
        (void)hipGetLastError();
        grid = cus * per_cu;
        fprintf(stderr, "kernel_launch: grid %d (%d CUs x %d)\n", grid, cus, per_cu);
    }
    if (grid < 0) return;
    if (hipMemsetAsync((char*)d_ws + WS_BAR, 0, 16 * KiB + 16 * 256, stream) != hipSuccess) { fprintf(stderr, "kernel_launch: memset failed\n"); return; }
    Args a{};
    for (int i = 0; i < 26; ++i) a.in[i] = (const float*)d_in[i];
    a.out = (float*)d_out; a.ws = (unsigned char*)d_ws; a.ph_lo = 0; a.ph_hi = 1 << 20;
    void* params[] = {&a};
    hipError_t e = hipLaunchCooperativeKernel((const void*)mk_fwd, dim3(grid), dim3(NWAVES * 64), params, LDS_BYTES, stream);
    if (e != hipSuccess) fprintf(stderr, "kernel_launch: cooperative launch failed: %s (grid %d)\n", hipGetErrorString(e), grid);
}
```
